# Optimizing an MI355X kernel written in HIP

```python
import jax
import jax.numpy as jnp
from jax import lax
import numpy as np

D_MODEL = 1024
BATCH = 4
SEQ = 4096
DEPTH = 1

CHUNK = 64
Q_BLOCK = 128
FOX_HEAD_DIM = 64
FOX_WIDTH = D_MODEL // 2
FOX_HEADS = FOX_WIDTH // FOX_HEAD_DIM
MLSTM_HEAD_DIM = 128
MLSTM_WIDTH = D_MODEL - FOX_WIDTH
MLSTM_HEADS = MLSTM_WIDTH // MLSTM_HEAD_DIM
MIX_WIDTH = FOX_WIDTH + MLSTM_WIDTH
CONV_WIDTH = 4
D_FF = 2816
N_MOD = 9
EPS = 1e-6
IN_SIZES = (FOX_WIDTH, FOX_WIDTH, FOX_WIDTH, FOX_HEADS,
            MLSTM_WIDTH, MLSTM_WIDTH, MLSTM_WIDTH, MLSTM_WIDTH, MLSTM_HEADS, MLSTM_HEADS)
IN_COLS = sum(IN_SIZES)

kernel_name = 'hymba_fox_mlstm_macaron_adaln'


def _split_points(sizes):
    pts, acc = [], 0
    for s in sizes[:-1]:
        acc += s
        pts.append(acc)
    return pts


def rms_normalize(x):
    xf = x.astype(jnp.float32)
    y = xf * lax.rsqrt(jnp.mean(xf * xf, axis=-1, keepdims=True) + EPS)
    return y.astype(x.dtype)


def modulate(h, shift, scale):
    return h * (1 + scale[:, None, :]) + shift[:, None, :]


def swiglu(h, w_in, w_out):
    g, u = jnp.split(h @ w_in, 2, axis=-1)
    return (jax.nn.silu(g) * u) @ w_out


def to_heads(t, n_heads):
    b, s, _ = t.shape
    return t.reshape(b, s, n_heads, -1).transpose(0, 2, 1, 3)


def from_heads(t):
    b, h, s, d = t.shape
    return t.transpose(0, 2, 1, 3).reshape(b, s, h * d)


def causal_depthwise_conv(x, w, b):
    ch = x.shape[-1]
    y = lax.conv_general_dilated(
        x, w[:, None, :], window_strides=(1,), padding=[(CONV_WIDTH - 1, 0)],
        dimension_numbers=('NWC', 'WIO', 'NWC'), feature_group_count=ch)
    return y + b


def forgetting_attention(q, k, v, log_f):
    b, h, s, dh = q.shape
    nb = s // Q_BLOCK
    cum = jnp.cumsum(log_f, axis=-1)
    kpos = jnp.arange(s)
    qb = q.reshape(b, h, nb, Q_BLOCK, dh).transpose(2, 0, 1, 3, 4)
    cb = cum.reshape(b, h, nb, Q_BLOCK).transpose(2, 0, 1, 3)
    qpos = kpos.reshape(nb, Q_BLOCK)
    scale = dh ** -0.5

    def block(args):
        q_i, c_i, pos_i = args
        logits = jnp.einsum('bhqd,bhkd->bhqk', q_i, k).astype(jnp.float32) * scale
        logits = logits + c_i[..., :, None] - cum[..., None, :]
        logits = jnp.where(pos_i[:, None] >= kpos[None, :], logits, -jnp.inf)
        p = jax.nn.softmax(logits, axis=-1)
        return jnp.einsum('bhqk,bhkd->bhqd', p.astype(v.dtype), v)

    out = lax.map(block, (qb, cb, qpos))
    return out.transpose(1, 2, 0, 3, 4).reshape(b, h, s, dh)


def mlstm_chunkwise(q, k, v, i_pre, log_f):
    b, h, s, dh = q.shape
    nc = s // CHUNK
    f32 = jnp.float32
    qc = q.astype(f32).reshape(b, h, nc, CHUNK, dh)
    kc = (k.astype(f32) * dh ** -0.5).reshape(b, h, nc, CHUNK, dh)
    vc = v.astype(f32).reshape(b, h, nc, CHUNK, dh)
    ic = i_pre.reshape(b, h, nc, CHUNK)
    a = jnp.cumsum(log_f.reshape(b, h, nc, CHUNK), axis=-1)
    g = a[..., -1]
    w_end = g[..., None] - a + ic

    def step(carry, xs):
        c_mat, n_vec, m = carry
        k_j, v_j, w_j, g_j = xs
        m_new = jnp.maximum(g_j + m, jnp.max(w_j, axis=-1))
        decay = jnp.exp(g_j + m - m_new)
        wt = jnp.exp(w_j - m_new[..., None])
        c_new = decay[..., None, None] * c_mat + jnp.einsum('bhl,bhld,bhle->bhde', wt, v_j, k_j)
        n_new = decay[..., None] * n_vec + jnp.einsum('bhl,bhle->bhe', wt, k_j)
        return (c_new, n_new, m_new), (c_mat, n_vec, m)

    init = (jnp.zeros((b, h, dh, dh), f32), jnp.zeros((b, h, dh), f32), jnp.zeros((b, h), f32))
    xs = (kc.transpose(2, 0, 1, 3, 4), vc.transpose(2, 0, 1, 3, 4),
          w_end.transpose(2, 0, 1, 3), g.transpose(2, 0, 1))
    _, (c_st, n_st, m_st) = lax.scan(step, init, xs)
    c_st = c_st.transpose(1, 2, 0, 3, 4)
    n_st = n_st.transpose(1, 2, 0, 3)
    m_st = m_st.transpose(1, 2, 0)

    causal = jnp.tril(jnp.ones((CHUNK, CHUNK), dtype=bool))
    d_log = a[..., :, None] - a[..., None, :] + ic[..., None, :]
    d_log = jnp.where(causal, d_log, -jnp.inf)
    inter = a + m_st[..., None]
    m_t = jnp.maximum(inter, jnp.max(d_log, axis=-1))
    p = jnp.exp(d_log - m_t[..., None])
    inter_w = jnp.exp(inter - m_t)
    scores = jnp.einsum('bhntd,bhnsd->bhnts', qc, kc) * p
    num = (jnp.einsum('bhnts,bhnsd->bhntd', scores, vc)
           + inter_w[..., None] * jnp.einsum('bhnde,bhnte->bhntd', c_st, qc))
    den = scores.sum(-1) + inter_w * jnp.einsum('bhne,bhnte->bhnt', n_st, qc)
    out = num / jnp.maximum(jnp.abs(den), jnp.exp(-m_t))[..., None]
    return out.reshape(b, h, s, dh)


def hybrid_mixer(h, w_in, b_fox_f, b_m_i, b_m_f, w_conv, b_conv, g_mhn, w_out):
    b, s, _ = h.shape
    f32 = jnp.float32
    proj = h @ w_in
    fq, fk, fv, ff, mq, mk, mv, mo, mi, mf = jnp.split(proj, _split_points(IN_SIZES), axis=-1)
    log_f_a = jax.nn.log_sigmoid((ff + b_fox_f).astype(f32)).transpose(0, 2, 1)
    y_a = from_heads(forgetting_attention(to_heads(fq, FOX_HEADS), to_heads(fk, FOX_HEADS),
                                          to_heads(fv, FOX_HEADS), log_f_a))
    qk = jax.nn.silu(causal_depthwise_conv(jnp.concatenate([mq, mk], axis=-1), w_conv, b_conv))
    mq_c, mk_c = jnp.split(qk, 2, axis=-1)
    i_pre = (mi + b_m_i).astype(f32).transpose(0, 2, 1)
    log_f_b = jax.nn.log_sigmoid((mf + b_m_f).astype(f32)).transpose(0, 2, 1)
    h_b = mlstm_chunkwise(to_heads(mq_c, MLSTM_HEADS), to_heads(mk_c, MLSTM_HEADS),
                          to_heads(mv, MLSTM_HEADS), i_pre, log_f_b)
    h_b = rms_normalize(h_b.transpose(0, 2, 1, 3)) * g_mhn.reshape(MLSTM_HEADS, MLSTM_HEAD_DIM).astype(f32)
    y_b = jax.nn.sigmoid(mo) * h_b.reshape(b, s, MLSTM_WIDTH).astype(h.dtype)
    return jnp.concatenate([y_a, y_b], axis=-1) @ w_out


def setup_inputs(seed: int = 0) -> dict:
    key = jax.random.key(seed)
    ks = jax.random.split(key, 20)
    f32 = jnp.float32

    def dense(k, shape, fan_in):
        return jax.random.normal(k, shape, f32) * fan_in ** -0.5

    def small(k, shape, s=0.02):
        return jax.random.normal(k, shape, f32) * s

    L = DEPTH
    return {
        'x': jax.random.normal(ks[0], (BATCH, SEQ, D_MODEL), f32),
        'c': jax.random.normal(ks[1], (BATCH, D_MODEL), f32),
        'w_ada': dense(ks[2], (L, D_MODEL, N_MOD * D_MODEL), D_MODEL),
        'b_ada': small(ks[3], (L, N_MOD * D_MODEL)),
        'w_ffn1_in': dense(ks[4], (L, D_MODEL, 2 * D_FF), D_MODEL),
        'w_ffn1_out': dense(ks[5], (L, D_FF, D_MODEL), D_FF),
        'w_mix_in': dense(ks[6], (L, D_MODEL, IN_COLS), D_MODEL),
        'b_fox_f': jnp.linspace(1.0, 5.0, FOX_HEADS, dtype=f32)[None] + small(ks[7], (L, FOX_HEADS), 0.1),
        'b_m_i': small(ks[8], (L, MLSTM_HEADS), 0.1),
        'b_m_f': jnp.linspace(3.0, 6.0, MLSTM_HEADS, dtype=f32)[None] + small(ks[9], (L, MLSTM_HEADS), 0.1),
        'w_conv': dense(ks[10], (L, CONV_WIDTH, 2 * MLSTM_WIDTH), CONV_WIDTH),
        'b_conv': small(ks[11], (L, 2 * MLSTM_WIDTH)),
        'g_mhn': 1.0 + small(ks[12], (L, MLSTM_WIDTH)),
        'w_mix_out': dense(ks[13], (L, MIX_WIDTH, D_MODEL), MIX_WIDTH),
        'w_ffn2_in': dense(ks[14], (L, D_MODEL, 2 * D_FF), D_MODEL),
        'w_ffn2_out': dense(ks[15], (L, D_FF, D_MODEL), D_FF),
        'g_final': 1.0 + small(ks[16], (D_MODEL,)),
    }


def reference(x, c, w_ada, b_ada, w_ffn1_in, w_ffn1_out, w_mix_in, b_fox_f, b_m_i, b_m_f,
              w_conv, b_conv, g_mhn, w_mix_out, w_ffn2_in, w_ffn2_out, g_final):
    c_act = jax.nn.silu(c)
    for layer in range(DEPTH):
        mod = c_act @ w_ada[layer] + b_ada[layer]
        (sh1, sc1, gt1, sh2, sc2, gt2, sh3, sc3, gt3) = jnp.split(mod, N_MOD, axis=-1)
        h = modulate(rms_normalize(x), sh1, sc1)
        x = x + 0.5 * gt1[:, None, :] * swiglu(h, w_ffn1_in[layer], w_ffn1_out[layer])
        h = modulate(rms_normalize(x), sh2, sc2)
        y = hybrid_mixer(h, w_mix_in[layer], b_fox_f[layer], b_m_i[layer], b_m_f[layer],
                         w_conv[layer], b_conv[layer], g_mhn[layer], w_mix_out[layer])
        x = x + gt2[:, None, :] * y
        h = modulate(rms_normalize(x), sh3, sc3)
        x = x + 0.5 * gt3[:, None, :] * swiglu(h, w_ffn2_in[layer], w_ffn2_out[layer])
    return rms_normalize(x) * g_final
```

```cpp
#include <hip/hip_runtime.h>
#include <cstdio>
#include <cstdint>
namespace pg8 {
#define PG8_LAS __attribute__((address_space(3)))
typedef unsigned short bf16_t;
typedef short bf16x8 __attribute__((ext_vector_type(8)));
typedef float f32x4 __attribute__((ext_vector_type(4)));
typedef unsigned u32x4 __attribute__((ext_vector_type(4)));
constexpr int BM = 256, BK = 64, HALF = 128, HTB = HALF * BK * 2  , STAGE_BYTES = 8 * HTB, NXCD = 8, WGM = 8;

__host__ __device__ __forceinline__ int lds_byte(int r, int c) { const int st = (r >> 4) * 2 + (c >> 5), rr = r & 15, cc = c & 31, ob = rr * 64 + cc * 2; return st * 1024 + (ob ^ (((ob >> 9) & 1) << 5)); }
__host__ __device__ __forceinline__ void stage_rc(int b, int& R, int& C) { const int st = b / 1024, sb = b % 1024, swz = sb ^ (((sb >> 9) & 1) << 5); R = (st >> 1) * 16 + swz / 64; C = (st & 1) * 32 + (swz % 64) / 2; }
__host__ __device__ __forceinline__ int perm32(int rho) { const int n = rho >> 4, i = rho & 15; return 8 * (i >> 2) + 4 * n + (i & 3); }

struct Unit { int pm, pn; };
struct Gemm { const bf16_t* A; const bf16_t* Bt; int M, N, K; };

struct StaticOrder {
    int nM, nN, nwg, G, c;
    __host__ __device__ void init(int M, int N, int G_, int c_) { nM = M / BM; nN = N / BM; nwg = nM * nN; G = G_; c = c_; }
    __host__ __device__ bool next(int i, Unit& u) const {
        const long L = (long)i * G + c; if (L >= nwg) return false;
        int wgid = (int)L; { const int q = nwg / NXCD, r = nwg % NXCD, xcd = wgid % NXCD, off = wgid / NXCD; wgid = (xcd < r ? xcd * (q + 1) : r * (q + 1) + (xcd - r) * q) + off; }
        const int nig = WGM * nN, gid = wgid / nig, fm = gid * WGM, gsz = (nM - fm) < WGM ? (nM - fm) : WGM;
        u.pm = fm + ((wgid % nig) % gsz); u.pn = (wgid % nig) / gsz; return true;
    }
    __device__ __forceinline__ void a_ready(const Unit&) const {}
    __device__ __forceinline__ void done(const Unit&) const {}
};

__device__ __forceinline__ unsigned cvt_pk_bf16(float lo, float hi) { unsigned r; asm volatile("v_cvt_pk_bf16_f32 %0, %1, %2" : "=v"(r) : "v"(lo), "v"(hi)); return r; }
typedef float f32x2 __attribute__((ext_vector_type(2)));
__device__ __forceinline__ float silu_f(float g) { return g * __builtin_amdgcn_rcpf(1.0f + __builtin_amdgcn_exp2f(-1.4426950408889634f * g)); }

struct EpiSwiglu {
    static constexpr bool PERM = true, AFTER_DRAIN = false;
    bf16_t* O; int ldc;
    __device__ __forceinline__ void operator()(const f32x4 (&acc)[2][2][4][2], const Unit& u, int wr, int wc, int fr, int fq) const {
        const int row0 = u.pm * BM + wr * 64 + fr, col0 = u.pn * HALF + wc * 32 + 8 * fq;
#pragma unroll
        for (int ai = 0; ai < 2; ++ai)
#pragma unroll
            for (int m = 0; m < 4; ++m) { bf16_t* rowp = O + (size_t)(row0 + ai * HALF + m * 16) * ldc + col0;
                const f32x4 g0 = acc[ai][0][m][0], g1 = acc[ai][0][m][1], u0 = acc[ai][1][m][0], u1 = acc[ai][1][m][1];
                f32x4 v0, v1;
#pragma unroll
                for (int j = 0; j < 4; ++j) { v0[j] = silu_f(g0[j]) * u0[j]; v1[j] = silu_f(g1[j]) * u1[j]; }
                u32x4 w; w.x = cvt_pk_bf16(v0[0], v0[1]); w.y = cvt_pk_bf16(v0[2], v0[3]); w.z = cvt_pk_bf16(v1[0], v1[1]); w.w = cvt_pk_bf16(v1[2], v1[3]);
                *(u32x4*)rowp = w; }
    }
};

struct EpiResGate {
    static constexpr bool PERM = false, AFTER_DRAIN = false;
    const float* base; float* out; int ldc; const float* gate; int gstride; int rows_per_batch; float gs;
    __device__ __forceinline__ void operator()(const f32x4 (&acc)[2][2][4][2], const Unit& u, int wr, int wc, int fr, int fq) const {
        const int row0 = u.pm * BM + wr * 64 + fr, col0 = u.pn * BM + wc * 32 + 4 * fq;
        const float* gb = gate + (size_t)((u.pm * BM) / rows_per_batch) * gstride + col0;
        f32x4 gv[2][2];
#pragma unroll
        for (int bj = 0; bj < 2; ++bj)
#pragma unroll
            for (int n = 0; n < 2; ++n) gv[bj][n] = *(const f32x4*)(gb + bj * HALF + n * 16) * gs;
#pragma unroll
        for (int ai = 0; ai < 2; ++ai)
#pragma unroll
            for (int m = 0; m < 4; ++m) { const size_t off = (size_t)(row0 + ai * HALF + m * 16) * ldc + col0;
#pragma unroll
                for (int bj = 0; bj < 2; ++bj)
#pragma unroll
                    for (int n = 0; n < 2; ++n) { const f32x4 bs = *(const f32x4*)(base + off + bj * HALF + n * 16); *(f32x4*)(out + off + bj * HALF + n * 16) = bs + gv[bj][n] * acc[ai][bj][m][n]; } }
    }
};

struct EpiMix {
    static constexpr bool PERM = true, AFTER_DRAIN = false;
    bf16_t* Y; bf16_t* MIXB; size_t mix_stride; float* GATES; float qscale;
    __device__ __forceinline__ void operator()(const f32x4 (&acc)[2][2][4][2], const Unit& u, int wr, int wc, int fr, int fq) const {
        const int row0 = u.pm * BM + wr * 64 + fr;
        if (u.pn == 14) {
            if (wc == 0 && fq < 2) {
#pragma unroll
                for (int ai = 0; ai < 2; ++ai)
#pragma unroll
                    for (int m = 0; m < 4; ++m) { float* gp = GATES + (size_t)(row0 + ai * HALF + m * 16) * 16 + 8 * fq;
                        *(f32x4*)gp = acc[ai][0][m][0]; *(f32x4*)(gp + 4) = acc[ai][0][m][1]; }
            }
            return;
        }
        const int t = u.pn >> 1; const int col0 = (u.pn & 1) * BM + wc * 32 + 8 * fq;
        bf16_t* base; int ldc; float sc;
        if (t == 0) { base = Y; ldc = 1024; sc = qscale; } else { base = MIXB + (size_t)(t - 1) * mix_stride; ldc = 512; sc = 1.0f; }
#pragma unroll
        for (int ai = 0; ai < 2; ++ai)
#pragma unroll
            for (int m = 0; m < 4; ++m) { bf16_t* rowp = base + (size_t)(row0 + ai * HALF + m * 16) * ldc + col0;
#pragma unroll
                for (int bj = 0; bj < 2; ++bj) { const f32x4 v0 = acc[ai][bj][m][0] * sc, v1 = acc[ai][bj][m][1] * sc;
                    u32x4 w; w.x = cvt_pk_bf16(v0[0], v0[1]); w.y = cvt_pk_bf16(v0[2], v0[3]); w.z = cvt_pk_bf16(v1[0], v1[1]); w.w = cvt_pk_bf16(v1[2], v1[3]);
                    *(u32x4*)(rowp + bj * HALF) = w; } }
    }
};

template <class Epi, class Sched, bool ALIGN_EPI = false, bool SP2 = false>
__device__ __forceinline__ void gemm_phase(PG8_LAS unsigned char* lds, const Gemm g, const Sched& S, const Epi& E) {
    const int tid = threadIdx.x, wid = __builtin_amdgcn_readfirstlane(tid >> 6), lane = tid & 63, wr = wid >> 2, wc = wid & 3, fr = lane & 15, fq = lane >> 4;
    const int K = g.K, nt = K / BK;
    unsigned voffA[2], voffB[2];
#pragma unroll
    for (int i = 0; i < 2; ++i) { int R, C; stage_rc(tid * 16 + i * 8192, R, C); const int Rb = Epi::PERM ? ((R & ~31) + perm32(R & 31)) : R;
        voffA[i] = (unsigned)(R * K + C) * 2u; voffB[i] = (unsigned)(Rb * K + C) * 2u; }
    const size_t kstep = (size_t)(BK * 2);
    const size_t hstep = (size_t)HALF * K * 2;
    const size_t tstep = 2 * hstep;
    const unsigned ldsw = (unsigned)wid * 1024u;
    const int aoff = lds_byte(wr * 64 + fr, fq * 8), boff = lds_byte(wc * 32 + fr, fq * 8);
#define PG8_SA(b, h) (((b) * 2 + (h)) * HTB)
#define PG8_SB(b, h) ((4 + (b) * 2 + (h)) * HTB)
#define PG8_STAGE(bufoff, gbase, voff) do { _Pragma("unroll") for (int _i = 0; _i < 2; ++_i) \
        __builtin_amdgcn_global_load_lds((const unsigned*)((const char*)(gbase) + (voff)[_i]), (PG8_LAS unsigned*)(lds + (bufoff) + ldsw + _i * 8192), 16, 0, 0); } while (0)
#define PG8_LDA(dst, b, h) do { _Pragma("unroll") for (int m = 0; m < 4; ++m) _Pragma("unroll") for (int k = 0; k < 2; ++k) dst[m][k] = *(const PG8_LAS bf16x8*)(lds + PG8_SA(b, h) + aoff + m * 2048 + k * 1024); } while (0)
#define PG8_LDB(dst, b, h) do { _Pragma("unroll") for (int n = 0; n < 2; ++n) _Pragma("unroll") for (int k = 0; k < 2; ++k) dst[n][k] = *(const PG8_LAS bf16x8*)(lds + PG8_SB(b, h) + boff + n * 2048 + k * 1024); } while (0)
#define PG8_MMA(ai, bj, At, Bt) do { __builtin_amdgcn_s_setprio(1); _Pragma("unroll") for (int m = 0; m < 4; ++m) _Pragma("unroll") for (int n = 0; n < 2; ++n) _Pragma("unroll") for (int k = 0; k < 2; ++k) \
        acc[ai][bj][m][n] = __builtin_amdgcn_mfma_f32_16x16x32_bf16(Bt[n][k], At[m][k], acc[ai][bj][m][n], 0, 0, 0); __builtin_amdgcn_s_setprio(0); } while (0)
#define PG8_WAIT_V(n) asm volatile("s_waitcnt vmcnt(" #n ")" ::: "memory")
#define PG8_WAIT_L(n) asm volatile("s_waitcnt lgkmcnt(" #n ")" ::: "memory")
#define PG8_BAR __builtin_amdgcn_s_barrier()
#define PG8_SCHED __builtin_amdgcn_sched_barrier(0)
    Unit cur, nxt; int ui = 0;
    if (!S.next(0, cur)) return;
    f32x4 acc[2][2][4][2];
#pragma unroll
    for (int a = 0; a < 2; ++a)
#pragma unroll
        for (int b = 0; b < 2; ++b)
#pragma unroll
            for (int m = 0; m < 4; ++m)
#pragma unroll
                for (int n = 0; n < 2; ++n) acc[a][b][m][n] = (f32x4){0.f, 0.f, 0.f, 0.f};
    bf16x8 At[4][2], B0[2][2], B1[2][2];
    const char* cA = (const char*)g.A + (size_t)cur.pm * tstep; const char* cB = (const char*)g.Bt + (size_t)cur.pn * tstep;
    S.a_ready(cur);
    if constexpr (SP2) {
        PG8_STAGE(PG8_SB(0, 0), cB, voffB); PG8_STAGE(PG8_SB(0, 1), cB + hstep, voffB); PG8_STAGE(PG8_SA(0, 0), cA, voffA); PG8_STAGE(PG8_SA(0, 1), cA + hstep, voffA);
        if (wr == 1) PG8_BAR;
        PG8_WAIT_V(2); PG8_BAR;
        PG8_STAGE(PG8_SB(1, 0), cB + kstep, voffB); PG8_STAGE(PG8_SA(1, 0), cA + kstep, voffA); PG8_STAGE(PG8_SB(1, 1), cB + hstep + kstep, voffB);
        PG8_WAIT_V(6); PG8_BAR;
    } else {
        PG8_STAGE(PG8_SB(0, 0), cB, voffB); PG8_STAGE(PG8_SA(0, 0), cA, voffA); PG8_STAGE(PG8_SB(0, 1), cB + hstep, voffB); PG8_STAGE(PG8_SA(0, 1), cA + hstep, voffA);
        if (wr == 1) PG8_BAR;
        PG8_WAIT_V(4); PG8_BAR;
        PG8_STAGE(PG8_SB(1, 0), cB + kstep, voffB); PG8_STAGE(PG8_SA(1, 0), cA + kstep, voffA); PG8_STAGE(PG8_SB(1, 1), cB + hstep + kstep, voffB);
        PG8_WAIT_V(6); PG8_BAR;
    }
    for (;;) {
        const bool has_next = S.next(ui + 1, nxt);
        const char* nA = has_next ? (const char*)g.A + (size_t)nxt.pm * tstep : cA; const char* nB = has_next ? (const char*)g.Bt + (size_t)nxt.pn * tstep : cB;
        for (int t = 0; t < nt; t += 2) {
            const bool last = (t == nt - 2);
            const char* a1 = cA + (size_t)(t + 1) * kstep;
            const char* a2 = last ? nA : cA + (size_t)(t + 2) * kstep; const char* b2 = last ? nB : cB + (size_t)(t + 2) * kstep;
            const char* a3 = a2 + kstep; const char* b3 = b2 + kstep;
            if (last && has_next) S.a_ready(nxt);
            if constexpr (SP2) {
            PG8_LDB(B0, 0, 0); PG8_LDB(B1, 0, 1); PG8_SCHED; PG8_LDA(At, 0, 0); PG8_STAGE(PG8_SA(1, 1), a1 + hstep, voffA);
            PG8_WAIT_V(8); PG8_WAIT_L(0); PG8_BAR; PG8_MMA(0, 0, At, B0); PG8_MMA(0, 1, At, B1); PG8_BAR; PG8_SCHED;
            PG8_LDA(At, 0, 1); PG8_STAGE(PG8_SB(0, 0), b2, voffB); PG8_STAGE(PG8_SB(0, 1), b2 + hstep, voffB); PG8_STAGE(PG8_SA(0, 0), a2, voffA);
            PG8_WAIT_V(8); PG8_WAIT_L(0); PG8_BAR; PG8_MMA(1, 0, At, B0); PG8_MMA(1, 1, At, B1); PG8_BAR; PG8_SCHED;
            PG8_LDB(B0, 1, 0); PG8_LDB(B1, 1, 1); PG8_SCHED; PG8_LDA(At, 1, 0); PG8_STAGE(PG8_SA(0, 1), a2 + hstep, voffA);
            PG8_WAIT_V(8); PG8_WAIT_L(0); PG8_BAR; PG8_MMA(0, 0, At, B0); PG8_MMA(0, 1, At, B1); PG8_BAR; PG8_SCHED;
            PG8_LDA(At, 1, 1); PG8_STAGE(PG8_SB(1, 0), b3, voffB); PG8_STAGE(PG8_SB(1, 1), b3 + hstep, voffB); PG8_STAGE(PG8_SA(1, 0), a3, voffA);
            PG8_WAIT_V(8); PG8_WAIT_L(0); PG8_BAR; PG8_MMA(1, 0, At, B0); PG8_MMA(1, 1, At, B1); PG8_BAR; PG8_SCHED;
            } else {
            PG8_LDB(B0, 0, 0); PG8_SCHED; PG8_LDA(At, 0, 0); PG8_STAGE(PG8_SA(1, 1), a1 + hstep, voffA);
            PG8_WAIT_L(8); PG8_BAR; PG8_WAIT_L(0); PG8_MMA(0, 0, At, B0); PG8_BAR; PG8_SCHED;
            PG8_LDB(B1, 0, 1); PG8_STAGE(PG8_SB(0, 0), b2, voffB);
            PG8_BAR; PG8_WAIT_L(0); PG8_MMA(0, 1, At, B1); PG8_BAR;
            PG8_LDA(At, 0, 1); PG8_STAGE(PG8_SA(0, 0), a2, voffA);
            PG8_BAR; PG8_WAIT_L(0); PG8_MMA(1, 0, At, B0); PG8_BAR; PG8_SCHED;
            PG8_STAGE(PG8_SB(0, 1), b2 + hstep, voffB);
            PG8_WAIT_V(6); PG8_BAR; PG8_MMA(1, 1, At, B1); PG8_BAR;
            PG8_LDB(B0, 1, 0); PG8_SCHED; PG8_LDA(At, 1, 0); PG8_STAGE(PG8_SA(0, 1), a2 + hstep, voffA);
            PG8_WAIT_L(8); PG8_BAR; PG8_WAIT_L(0); PG8_MMA(0, 0, At, B0); PG8_BAR; PG8_SCHED;
            PG8_LDB(B1, 1, 1); PG8_STAGE(PG8_SB(1, 0), b3, voffB);
            PG8_BAR; PG8_WAIT_L(0); PG8_MMA(0, 1, At, B1); PG8_BAR;
            PG8_LDA(At, 1, 1); PG8_STAGE(PG8_SA(1, 0), a3, voffA);
            PG8_BAR; PG8_WAIT_L(0); PG8_MMA(1, 0, At, B0); PG8_BAR; PG8_SCHED;
            PG8_STAGE(PG8_SB(1, 1), b3 + hstep, voffB);
            PG8_WAIT_V(6); PG8_BAR; PG8_MMA(1, 1, At, B1); PG8_BAR;
            }
        }
        if constexpr (ALIGN_EPI) { if (wr == 0) PG8_BAR; }
        if constexpr (!Epi::AFTER_DRAIN) { E(acc, cur, wr, wc, fr, fq); S.done(cur); }
        if (!has_next) break;
#pragma unroll
        for (int a = 0; a < 2; ++a)
#pragma unroll
            for (int b = 0; b < 2; ++b)
#pragma unroll
                for (int m = 0; m < 4; ++m)
#pragma unroll
                    for (int n = 0; n < 2; ++n) acc[a][b][m][n] = (f32x4){0.f, 0.f, 0.f, 0.f};
        cur = nxt; cA = nA; cB = nB; ++ui;
        if constexpr (ALIGN_EPI) { if (wr == 1) PG8_BAR; }
    }
    PG8_WAIT_V(0);
    if constexpr (!ALIGN_EPI) { if (wr == 0) PG8_BAR; }
    PG8_BAR;
    if constexpr (Epi::AFTER_DRAIN) { E.fused(acc, cur, wr, wc, fr, fq, lds, wid, lane); S.done(cur); }
#undef PG8_SA
#undef PG8_SB
#undef PG8_STAGE
#undef PG8_LDA
#undef PG8_LDB
#undef PG8_MMA
#undef PG8_WAIT_V
#undef PG8_WAIT_L
#undef PG8_BAR
#undef PG8_SCHED
}
}
constexpr int NWAVES = 8;
constexpr int BATCH = 4, SEQ = 4096, D = 1024, FF = 2816, NMOD = 9 * D;
constexpr int M = BATCH * SEQ;
constexpr int MIXN = 3600;
constexpr int MIXNP = 3840;
constexpr float EPS = 1e-6f;
constexpr float QSCALE = 0.125f * 1.4426950408889634f;

constexpr size_t MiB = 1u << 20;
constexpr size_t WS_CTL = 0, CTL_ZERO_BYTES = 1 * MiB;
constexpr size_t WS_MOD = 1 * MiB, WS_GATES = 2 * MiB;
constexpr size_t WS_W1I = 4 * MiB, WS_W1O = 15 * MiB, WS_WMI = 21 * MiB, WS_WMO = 29 * MiB, WS_W2I = 31 * MiB, WS_W2O = 42 * MiB;
constexpr size_t WS_XN = 48 * MiB;
constexpr size_t WS_Y = 80 * MiB;
constexpr size_t WS_ACT = 112 * MiB;
constexpr size_t WS_END = 208 * MiB;
static_assert(WS_W1I + (size_t)2 * FF * D * 2 <= WS_W1O && WS_W1O + (size_t)D * FF * 2 <= WS_WMI && WS_WMI + (size_t)MIXNP * D * 2 <= WS_WMO && WS_WMO + (size_t)D * D * 2 <= WS_W2I &&
              WS_W2I + (size_t)2 * FF * D * 2 <= WS_W2O && WS_W2O + (size_t)D * FF * 2 <= WS_XN && WS_XN + (size_t)M * D * 2 <= WS_Y && WS_Y + (size_t)M * D * 2 <= WS_ACT &&
              WS_ACT + (size_t)6 * M * 512 * 2 <= WS_END && WS_ACT + (size_t)M * FF * 2 <= WS_END && WS_MOD + (size_t)BATCH * NMOD * 4 <= WS_GATES && WS_GATES + (size_t)M * 16 * 4 <= WS_W1I, "d_ws map");
constexpr int CW_QUEUE = 64;
constexpr int CW_BAR = 4096;

constexpr int RING_OFF = 0, RING_BYTES = 131072;
constexpr int LDSCTL_OFF = RING_BYTES, MISC_OFF = LDSCTL_OFF + 320;
constexpr int LDS_BYTES = 147456;
static_assert(MISC_OFF + 128 <= LDS_BYTES, "LDS map");

#define GAS __attribute__((address_space(1)))
#define LAS __attribute__((address_space(3)))
typedef unsigned short bf16;
typedef unsigned v4u __attribute__((ext_vector_type(4)));
typedef float f32x4 __attribute__((ext_vector_type(4)));
typedef short bf16x8 __attribute__((ext_vector_type(8)));
typedef GAS unsigned gu32;
typedef GAS unsigned long long gu64;
#define RLX_AGENT __ATOMIC_RELAXED, __HIP_MEMORY_SCOPE_AGENT
#define LDS_WAIT() asm volatile("s_waitcnt lgkmcnt(0)" ::: "memory")
#define VM_WAIT() asm volatile("s_waitcnt vmcnt(0)" ::: "memory")
__device__ __forceinline__ unsigned long long rt() { return __builtin_amdgcn_s_memrealtime(); }
__device__ __forceinline__ unsigned f2bf(float f) { unsigned u = __builtin_bit_cast(unsigned, f); return (u + 0x7fffu + ((u >> 16) & 1u)) >> 16; }
__device__ __forceinline__ unsigned pk2(float lo, float hi) { return f2bf(lo) | (f2bf(hi) << 16); }

#define XB_TMO      128
#define XB_XCNT(j)  (256  + 64 * (j))
#define XB_XSUB(j)  (1280 + 64 * (j))
#define XB_XGEN(j)  (2304 + 64 * (j))
#define XB_TOP      3328
#define XB_TOPGEN   3392
#define XCD_BAR_WORDS 3456
#define XB_SPIN_CAP (1u << 18)

__device__ __forceinline__ unsigned xb_ld(unsigned* p)              { return __hip_atomic_load(p, __ATOMIC_RELAXED, __HIP_MEMORY_SCOPE_AGENT); }
__device__ __forceinline__ unsigned xb_add(unsigned* p, unsigned v) { return __hip_atomic_fetch_add(p, v, __ATOMIC_RELAXED, __HIP_MEMORY_SCOPE_AGENT); }
__device__ __forceinline__ unsigned xb_xcc_id() { return (unsigned)__builtin_amdgcn_s_getreg((3 << 11) | 20) & 0xFu; }
#define XB_SPIN(cond, bar) do { unsigned _sp = 0; while (cond) { __builtin_amdgcn_s_sleep(1); \
    if ((++_sp & 255u) == 0u) { if (xb_ld(&(bar)[XB_TMO])) break; if (_sp > XB_SPIN_CAP) { atomicAdd(&(bar)[XB_TMO], 1u); break; } } } } while (0)

struct XcdBarrier {
    unsigned* bar; unsigned x;
    volatile LAS unsigned* st;
};

__device__ __forceinline__ XcdBarrier xcd_barrier_post(unsigned* bar, volatile LAS unsigned* st) {
    XcdBarrier b; b.bar = bar; b.x = xb_xcc_id(); b.st = st;
    if (threadIdx.x == 0) (void)xb_add(&bar[XB_XCNT(b.x)], 1u);
    return b;
}
__device__ __forceinline__ void xcd_barrier_complete(unsigned* bar, unsigned x, unsigned& nloc, unsigned& nx) {
    const unsigned G = gridDim.x * gridDim.y * gridDim.z;
    unsigned sum, cnt, mine, sp = 0u;
    for (;;) {
        sum = 0u; cnt = 0u; mine = 0u;
#pragma unroll
        for (unsigned j = 0; j < 16; ++j) { const unsigned c = xb_ld(&bar[XB_XCNT(j)]); sum += c; cnt += (c > 0u) ? 1u : 0u; mine = (j == x) ? c : mine; }
        if (sum == G) break;
        __builtin_amdgcn_s_sleep(1);
        if ((++sp & 255u) == 0u) { if (xb_ld(&bar[XB_TMO])) break; if (sp > XB_SPIN_CAP) { atomicAdd(&bar[XB_TMO], 1u); break; } }
    }
    nloc = mine > 0u ? mine : 1u; nx = cnt > 0u ? cnt : 1u;
}

__device__ __forceinline__ void xcd_barrier(const XcdBarrier& b) {
    asm volatile("s_waitcnt vmcnt(0)" ::: "memory");
    __syncthreads();
    if (threadIdx.x == 0) {
        unsigned* bar = b.bar;
        __builtin_amdgcn_s_waitcnt(0);
        unsigned nloc = b.st[0], nx = b.st[1];
        if (nloc == 0u) { xcd_barrier_complete(bar, b.x, nloc, nx); b.st[0] = nloc; b.st[1] = nx; }
        const unsigned old = xb_add(&bar[XB_XSUB(b.x)], 1u);
        const unsigned gen = old / nloc;
        if (old + 1u == (gen + 1u) * nloc) {
            __builtin_amdgcn_fence(__ATOMIC_RELEASE, "agent");
            asm volatile("s_waitcnt vmcnt(0)" ::: "memory");
            const unsigned og = xb_add(&bar[XB_TOP], 1u);
            const unsigned tg = og / nx;
            if (og + 1u == (tg + 1u) * nx) xb_add(&bar[XB_TOPGEN], 1u);
            else XB_SPIN(xb_ld(&bar[XB_TOPGEN]) == tg, bar);
            __builtin_amdgcn_fence(__ATOMIC_ACQUIRE, "agent");
            xb_add(&bar[XB_XGEN(b.x)], 1u);
            asm volatile("s_waitcnt vmcnt(0)" ::: "memory");
        } else {
            XB_SPIN(xb_ld(&bar[XB_XGEN(b.x)]) == gen, bar);
            __builtin_amdgcn_fence(__ATOMIC_ACQUIRE, "agent");
            asm volatile("s_waitcnt vmcnt(0)" ::: "memory");
        }
    }
    __syncthreads();
}

struct Args { const float* in[17]; float* out; unsigned char* ws; };
typedef const __attribute__((address_space(4))) Args* KArgs;
struct Frame {
    LAS unsigned char* lds;
    volatile LAS unsigned* MISC;
    int tid, lane, wave;
    int vcu, G;
    __device__ __forceinline__ const float* in(int i) const { return ((KArgs)__builtin_amdgcn_kernarg_segment_ptr())->in[i]; }
    __device__ __forceinline__ float* out() const { return ((KArgs)__builtin_amdgcn_kernarg_segment_ptr())->out; }
    __device__ __forceinline__ unsigned char* ws() const { return ((KArgs)__builtin_amdgcn_kernarg_segment_ptr())->ws; }
    __device__ __forceinline__ const float* x() const { return in(0); }
    __device__ __forceinline__ const float* c() const { return in(1); }
    __device__ __forceinline__ const float* w_ada() const { return in(2); }
    __device__ __forceinline__ const float* b_ada() const { return in(3); }
    __device__ __forceinline__ const float* w1i() const { return in(4); }
    __device__ __forceinline__ const float* w1o() const { return in(5); }
    __device__ __forceinline__ const float* wmi() const { return in(6); }
    __device__ __forceinline__ const float* b_fox_f() const { return in(7); }
    __device__ __forceinline__ const float* b_m_i() const { return in(8); }
    __device__ __forceinline__ const float* b_m_f() const { return in(9); }
    __device__ __forceinline__ const float* w_conv() const { return in(10); }
    __device__ __forceinline__ const float* b_conv() const { return in(11); }
    __device__ __forceinline__ const float* g_mhn() const { return in(12); }
    __device__ __forceinline__ const float* wmo() const { return in(13); }
    __device__ __forceinline__ const float* w2i() const { return in(14); }
    __device__ __forceinline__ const float* w2o() const { return in(15); }
    __device__ __forceinline__ const float* g_final() const { return in(16); }
    __device__ __forceinline__ gu32* ctl() const { return (gu32*)(ws() + WS_CTL); }
    __device__ __forceinline__ bf16* W1I_t() const { return (bf16*)(ws() + WS_W1I); }
    __device__ __forceinline__ bf16* W1O_t() const { return (bf16*)(ws() + WS_W1O); }
    __device__ __forceinline__ bf16* WMI_t() const { return (bf16*)(ws() + WS_WMI); }
    __device__ __forceinline__ bf16* WMO_t() const { return (bf16*)(ws() + WS_WMO); }
    __device__ __forceinline__ bf16* W2I_t() const { return (bf16*)(ws() + WS_W2I); }
    __device__ __forceinline__ bf16* W2O_t() const { return (bf16*)(ws() + WS_W2O); }
    __device__ __forceinline__ bf16* XN() const { return (bf16*)(ws() + WS_XN); }
    __device__ __forceinline__ bf16* Y() const { return (bf16*)(ws() + WS_Y); }
    __device__ __forceinline__ bf16* ACT() const { return (bf16*)(ws() + WS_ACT); }
    __device__ __forceinline__ bf16* MIXB() const { return (bf16*)(ws() + WS_ACT); }
    __device__ __forceinline__ float* MOD() const { return (float*)(ws() + WS_MOD); }
    __device__ __forceinline__ float* GATES() const { return (float*)(ws() + WS_GATES); }
    __device__ __forceinline__ float* HB() const { return (float*)(ws() + WS_XN); }
};

__device__ __forceinline__ float wave_sum(float v) {
#pragma unroll
    for (int o = 1; o < 64; o <<= 1) v += __shfl_xor(v, o);
    return v;
}
__device__ __forceinline__ float silu_d(float g) { return g / (1.0f + __expf(-g)); }
__device__ __forceinline__ float logsigmoid_d(float x) { return fminf(x, 0.0f) - log1pf(__expf(-fabsf(x))); }
__device__ __forceinline__ float bf2f(bf16 v) { return __uint_as_float((unsigned)v << 16); }

__device__ __forceinline__ void transpose_item(const float* W, int N, int Kd, int k0, int nsrc0, bf16* WT, int drow0, LAS float* scr, int lane) {
#pragma unroll 8
    for (int i = 0; i < 32; ++i) { const int kk = 2 * i + (lane >> 5); scr[kk * 33 + (lane & 31)] = W[(size_t)(k0 + kk) * N + nsrc0 + (lane & 31)]; }
    LDS_WAIT(); asm volatile("" ::: "memory");
    const int c = lane & 7;
#pragma unroll
    for (int j = 0; j < 4; ++j) { const int n = (lane >> 3) + 8 * j; const LAS float* s = scr + (8 * c) * 33 + n;
        v4u o; o.x = pk2(s[0 * 33], s[1 * 33]); o.y = pk2(s[2 * 33], s[3 * 33]); o.z = pk2(s[4 * 33], s[5 * 33]); o.w = pk2(s[6 * 33], s[7 * 33]);
        *(GAS v4u*)(WT + (size_t)(drow0 + n) * Kd + k0 + 8 * c) = o; }
    LDS_WAIT(); asm volatile("" ::: "memory");
}
__device__ __forceinline__ void gate_tile_item(const float* W, bf16* WT, int kb, int lane) {
    const int k = kb * 64 + lane;
    for (int r = 0; r < 256; ++r) {
        float v = 0.f;
        if (r < 16) { const int sc = (r < 8) ? (1536 + r) : (3592 + (r - 8)); v = W[(size_t)k * MIXN + sc]; }
        WT[(size_t)(3584 + r) * D + k] = (bf16)f2bf(v);
    }
}
__device__ __forceinline__ void ada_item(const Frame& F, int a, const LAS float* cact) {
    const int cl = F.lane & 7, kp = F.lane >> 3, col = 32 * a + 4 * cl;
    f32x4 acc[4];
#pragma unroll
    for (int b = 0; b < 4; ++b) acc[b] = (f32x4){0.f, 0.f, 0.f, 0.f};
    const float* wp = F.w_ada() + (size_t)kp * NMOD + col;
#pragma unroll 1
    for (int k0 = 0; k0 < D; k0 += 128) {
        f32x4 w[16];
#pragma unroll
        for (int i = 0; i < 16; ++i) w[i] = *(const GAS f32x4*)(wp + (size_t)(k0 + 8 * i) * NMOD);
#pragma unroll
        for (int i = 0; i < 16; ++i) { const int k = k0 + 8 * i + kp;
#pragma unroll
            for (int b = 0; b < 4; ++b) acc[b] += w[i] * cact[b * D + k]; }
    }
#pragma unroll
    for (int b = 0; b < 4; ++b)
#pragma unroll
        for (int j = 0; j < 4; ++j) { float v = acc[b][j]; v += __shfl_xor(v, 8); v += __shfl_xor(v, 16); v += __shfl_xor(v, 32); acc[b][j] = v; }
    if (kp == 0) { const f32x4 bb = *(const GAS f32x4*)(F.b_ada() + col);
#pragma unroll
        for (int b = 0; b < 4; ++b) *(GAS f32x4*)(F.MOD() + (size_t)b * NMOD + col) = acc[b] + bb; }
}

__device__ __forceinline__ void p0_prologue(Frame& F) {
    LAS float* scr = (LAS float*)(F.lds + F.wave * 8704);
    LAS float* cact = (LAS float*)(F.lds + 8 * 8704);
    for (int i = F.tid; i < BATCH * D; i += NWAVES * 64) cact[i] = silu_d(F.c()[i]);
    __syncthreads();
    if (F.wave == 0) { for (int a = F.vcu; a < NMOD / 32; a += 8 * F.G) ada_item(F, a, cact); }
    if (F.wave == 1) { for (int a = F.G + F.vcu; a < NMOD / 32; a += 8 * F.G) ada_item(F, a, cact); }
    const int gw = F.vcu * NWAVES + F.wave, NGW = F.G * NWAVES;
    constexpr int I_FI = (D / 64) * (2 * FF / 32), I_FO = (FF / 64) * (D / 32), I_MI = (D / 64) * (3584 / 32), I_MO = (D / 64) * (D / 32), I_G = D / 64;
    constexpr int NITEMS = 2 * I_FI + 2 * I_FO + I_MI + I_MO + I_G;
    for (int it = gw; it < NITEMS; it += NGW) {
        int r = it;
        if (r < 2 * I_FI) {
            const float* W = (r < I_FI) ? F.w1i() : F.w2i(); bf16* WT = (r < I_FI) ? F.W1I_t() : F.W2I_t(); if (r >= I_FI) r -= I_FI;
            const int nrb = 2 * FF / 32, kb = r / nrb, rb = r % nrb, drow = rb * 32, tile = drow >> 8, within = drow & 255, half = within >> 7, hid = tile * 128 + (within & 127);
            transpose_item(W, 2 * FF, D, kb * 64, half * FF + hid, WT, drow, scr, F.lane); continue; }
        r -= 2 * I_FI;
        if (r < 2 * I_FO) {
            const float* W = (r < I_FO) ? F.w1o() : F.w2o(); bf16* WT = (r < I_FO) ? F.W1O_t() : F.W2O_t(); if (r >= I_FO) r -= I_FO;
            const int nrb = D / 32, kb = r / nrb, rb = r % nrb;
            transpose_item(W, D, FF, kb * 64, rb * 32, WT, rb * 32, scr, F.lane); continue; }
        r -= 2 * I_FO;
        if (r < I_MI) {
            const int nrb = 3584 / 32, kb = r / nrb, rb = r % nrb, drow = rb * 32, t = drow >> 9, src = (t < 3 ? 512 * t : 512 * t + 8) + (drow & 511);
            transpose_item(F.wmi(), MIXN, D, kb * 64, src, F.WMI_t(), drow, scr, F.lane); continue; }
        r -= I_MI;
        if (r < I_MO) { const int nrb = D / 32, kb = r / nrb, rb = r % nrb; transpose_item(F.wmo(), D, D, kb * 64, rb * 32, F.WMO_t(), rb * 32, scr, F.lane); continue; }
        r -= I_MO;
        gate_tile_item(F.wmi(), F.WMI_t(), r, F.lane);
    }
}

__device__ __forceinline__ void norm_mod_rows(Frame& F, const float* src, bf16* dst, int shift_off, int scale_off) {
    const int gw = F.vcu * NWAVES + F.wave, NGW = F.G * NWAVES;
    for (int m = gw; m < M; m += NGW) {
        const GAS f32x4* xr = (const GAS f32x4*)(src + (size_t)m * D) + F.lane;
        const float* mb = F.MOD() + (size_t)(m / SEQ) * NMOD;
        f32x4 v[4]; float s = 0.f;
#pragma unroll
        for (int j = 0; j < 4; ++j) { v[j] = xr[64 * j]; s += (v[j].x * v[j].x + v[j].y * v[j].y) + (v[j].z * v[j].z + v[j].w * v[j].w); }
        const float rstd = 1.f / sqrtf(wave_sum(s) * (1.f / D) + EPS);
        GAS unsigned long long* o8 = (GAS unsigned long long*)(dst + (size_t)m * D) + F.lane;
#pragma unroll
        for (int j = 0; j < 4; ++j) { const f32x4 sh = *((const GAS f32x4*)(mb + shift_off) + F.lane + 64 * j), sc = *((const GAS f32x4*)(mb + scale_off) + F.lane + 64 * j);
            const f32x4 h = v[j] * rstd * (sc + 1.0f) + sh;
            o8[64 * j] = (unsigned long long)pk2(h.x, h.y) | ((unsigned long long)pk2(h.z, h.w) << 32); }
    }
}
__device__ __forceinline__ void final_norm_rows(Frame& F, float* xio) {
    const int gw = F.vcu * NWAVES + F.wave, NGW = F.G * NWAVES;
    for (int m = gw; m < M; m += NGW) {
        GAS f32x4* xr = (GAS f32x4*)(xio + (size_t)m * D) + F.lane;
        f32x4 v[4]; float s = 0.f;
#pragma unroll
        for (int j = 0; j < 4; ++j) { v[j] = xr[64 * j]; s += (v[j].x * v[j].x + v[j].y * v[j].y) + (v[j].z * v[j].z + v[j].w * v[j].w); }
        const float rstd = 1.f / sqrtf(wave_sum(s) * (1.f / D) + EPS);
#pragma unroll
        for (int j = 0; j < 4; ++j) { const f32x4 g = *((const GAS f32x4*)F.g_final() + F.lane + 64 * j); xr[64 * j] = v[j] * rstd * g; }
    }
}
__device__ __forceinline__ void mlstm_fixup_rows(Frame& F) {
    const int gw = F.vcu * NWAVES + F.wave, NGW = F.G * NWAVES;
    const bf16* MO = F.MIXB() + (size_t)5 * M * 512;
    for (int m = gw; m < M; m += NGW) {
        const GAS f32x4* hp = (const GAS f32x4*)(F.HB() + (size_t)m * 512 + 8 * F.lane);
        const f32x4 h0 = hp[0], h1 = hp[1];
        float s = (h0.x * h0.x + h0.y * h0.y) + (h0.z * h0.z + h0.w * h0.w) + (h1.x * h1.x + h1.y * h1.y) + (h1.z * h1.z + h1.w * h1.w);
        s += __shfl_xor(s, 1); s += __shfl_xor(s, 2); s += __shfl_xor(s, 4); s += __shfl_xor(s, 8);
        const float rstd = 1.f / sqrtf(s * (1.f / 128.f) + EPS);
        const v4u mo = *(const GAS v4u*)(MO + (size_t)m * 512 + 8 * F.lane);
        const GAS f32x4* gp = (const GAS f32x4*)(F.g_mhn() + 8 * F.lane); const f32x4 g0 = gp[0], g1 = gp[1];
        float o[8]; const float hh[8] = {h0.x, h0.y, h0.z, h0.w, h1.x, h1.y, h1.z, h1.w}; const float gg[8] = {g0.x, g0.y, g0.z, g0.w, g1.x, g1.y, g1.z, g1.w};
        const unsigned mw[4] = {mo.x, mo.y, mo.z, mo.w};
#pragma unroll
        for (int j = 0; j < 8; ++j) { const float mov = __uint_as_float((j & 1) ? (mw[j >> 1] & 0xffff0000u) : (mw[j >> 1] << 16)); o[j] = (1.0f / (1.0f + __expf(-mov))) * (hh[j] * rstd * gg[j]); }
        v4u w; w.x = pk2(o[0], o[1]); w.y = pk2(o[2], o[3]); w.z = pk2(o[4], o[5]); w.w = pk2(o[6], o[7]);
        *(GAS v4u*)(F.Y() + (size_t)m * D + 512 + 8 * F.lane) = w;
    }
}

__device__ __forceinline__ void fox_cumsum(Frame& F, int b, int h, int n, LAS float* cb, LAS float* scratch) {
    const float bias = F.b_fox_f()[h];
    const int i0 = F.tid * 8;
    float v[8]; float run = 0.f;
#pragma unroll
    for (int j = 0; j < 8; ++j) { float lf = 0.f; if (i0 + j < n) lf = logsigmoid_d(F.GATES()[(size_t)(b * SEQ + i0 + j) * 16 + h] + bias); run += lf; v[j] = run; }
    float tot = run;
#pragma unroll
    for (int o = 1; o < 64; o <<= 1) { const float t = __shfl_up(tot, o); if (F.lane >= o) tot += t; }
    if (F.lane == 63) scratch[F.wave] = tot;
    __syncthreads();
    float woff = 0.f;
#pragma unroll
    for (int w = 0; w < 8; ++w) { const float s = scratch[w]; if (w < F.wave) woff += s; }
    const float base = woff + tot - run;
#pragma unroll
    for (int j = 0; j < 8; ++j) if (i0 + j < n) cb[i0 + j] = (base + v[j]) * 1.4426950408889634f;
    __syncthreads();
}

__device__ __forceinline__ void attn_naive_unit(Frame& F, int b, int h, int qb) {
    LAS float* cb = (LAS float*)F.lds;
    LAS float* Ks = cb + 4096;
    LAS float* Vs = Ks + 4096;
    LAS float* scr = Vs + 4096;
    const bf16* FK = F.MIXB(); const bf16* FV = F.MIXB() + (size_t)M * 512;
    fox_cumsum(F, b, h, (qb + 1) * 256, cb, scr);
    const int r = F.tid & 255, dh = F.tid >> 8, t = qb * 256 + r; const size_t grow = (size_t)b * SEQ + t;
    unsigned qp[32]; float o[32];
    { const v4u* qptr = (const v4u*)(F.Y() + grow * D + h * 64);
#pragma unroll
      for (int c = 0; c < 8; ++c) { const v4u w = qptr[c]; qp[4 * c] = w.x; qp[4 * c + 1] = w.y; qp[4 * c + 2] = w.z; qp[4 * c + 3] = w.w; } }
#pragma unroll
    for (int d = 0; d < 32; ++d) o[d] = 0.f;
    float mrun = -1e30f, l = 0.f;
    const int NT = 4 * (qb + 1);
#pragma unroll 1
    for (int kt = 0; kt < NT; ++kt) {
        __syncthreads();
        { const int s = F.tid >> 3, d0 = (F.tid & 7) * 8; const size_t krow = (size_t)b * SEQ + kt * 64 + s;
          const v4u kw = *(const v4u*)(FK + krow * 512 + h * 64 + d0), vw = *(const v4u*)(FV + krow * 512 + h * 64 + d0);
          const unsigned kk[4] = {kw.x, kw.y, kw.z, kw.w}, vv[4] = {vw.x, vw.y, vw.z, vw.w};
#pragma unroll
          for (int j = 0; j < 4; ++j) { Ks[s * 64 + d0 + 2 * j] = __uint_as_float(kk[j] << 16); Ks[s * 64 + d0 + 2 * j + 1] = __uint_as_float(kk[j] & 0xffff0000u);
                                        Vs[s * 64 + d0 + 2 * j] = __uint_as_float(vv[j] << 16); Vs[s * 64 + d0 + 2 * j + 1] = __uint_as_float(vv[j] & 0xffff0000u); } }
        __syncthreads();
#pragma unroll 1
        for (int s = 0; s < 64; ++s) {
            const int kp = kt * 64 + s;
            if (kp <= t) {
                float dot = 0.f;
#pragma unroll
                for (int d = 0; d < 64; d += 4) { const f32x4 kv = *(const LAS f32x4*)(Ks + s * 64 + d);
                    dot += __uint_as_float(qp[d >> 1] << 16) * kv.x + __uint_as_float(qp[d >> 1] & 0xffff0000u) * kv.y + __uint_as_float(qp[(d >> 1) + 1] << 16) * kv.z + __uint_as_float(qp[(d >> 1) + 1] & 0xffff0000u) * kv.w; }
                const float sc = dot - cb[kp];
                if (sc > mrun) { const float f = exp2f(mrun - sc); l *= f;
#pragma unroll
                    for (int d = 0; d < 32; ++d) o[d] *= f;
                    mrun = sc; }
                const float p = exp2f(sc - mrun); l += p;
#pragma unroll
                for (int d = 0; d < 32; d += 4) { const f32x4 vv = *(const LAS f32x4*)(Vs + s * 64 + dh * 32 + d); o[d] += p * vv.x; o[d + 1] += p * vv.y; o[d + 2] += p * vv.z; o[d + 3] += p * vv.w; }
            }
        }
    }
    __syncthreads();
    { const float inv = 1.0f / l;
      v4u* op = (v4u*)(F.Y() + grow * D + h * 64 + dh * 32);
#pragma unroll
      for (int c = 0; c < 4; ++c) op[c] = (v4u){pk2(o[8 * c] * inv, o[8 * c + 1] * inv), pk2(o[8 * c + 2] * inv, o[8 * c + 3] * inv), pk2(o[8 * c + 4] * inv, o[8 * c + 5] * inv), pk2(o[8 * c + 6] * inv, o[8 * c + 7] * inv)}; }
    __syncthreads();
}

__device__ __forceinline__ void mlstm_naive_unit(Frame& F, int b, int h, int db) {
    LAS float* L = (LAS float*)F.lds;
    LAS float* qs = L;
    LAS float* ks = qs + 64 * 129;
    LAS float* vs = ks + 64 * 129;
    LAS float* Cs = vs + 64 * 33;
    LAS float* ns = Cs + 32 * 129;
    LAS float* Sm = ns + 128;
    LAS float* av = Sm + 64 * 65;
    LAS float* icv = av + 64;
    LAS float* mtv = icv + 64;
    LAS float* iwv = mtv + 64;
    LAS float* wtv = iwv + 64;
    LAS float* denv = wtv + 64;
    LAS float* scl = denv + 64;
    const bf16* MQ = F.MIXB() + (size_t)2 * M * 512; const bf16* MK = F.MIXB() + (size_t)3 * M * 512; const bf16* MV = F.MIXB() + (size_t)4 * M * 512;
    for (int i = F.tid; i < 32 * 129; i += 512) Cs[i] = 0.f;
    if (F.tid < 128) ns[F.tid] = 0.f;
    float mstate = 0.f;
    const float bi = F.b_m_i()[h], bfg = F.b_m_f()[h];
    __syncthreads();
#pragma unroll 1
    for (int j = 0; j < SEQ / 64; ++j) {
        const int t0 = 64 * j; const size_t grow0 = (size_t)b * SEQ + t0;
#pragma unroll 1
        for (int n = 0; n < 16; ++n) { const int idx = F.tid + 512 * n, t = idx >> 7, c = idx & 127, ch = h * 128 + c;
            float aq = F.b_conv()[ch], ak = F.b_conv()[512 + ch];
#pragma unroll
            for (int w = 0; w < 4; ++w) { const int tt = t0 + t - 3 + w; if (tt >= 0) { const size_t ro = ((size_t)b * SEQ + tt) * 512 + ch; aq += F.w_conv()[w * 1024 + ch] * bf2f(MQ[ro]); ak += F.w_conv()[w * 1024 + 512 + ch] * bf2f(MK[ro]); } }
            qs[t * 129 + c] = silu_d(aq); ks[t * 129 + c] = silu_d(ak) * 0.08838834764831845f; }
#pragma unroll 1
        for (int n = 0; n < 4; ++n) { const int idx = F.tid + 512 * n, t = idx >> 5, d = idx & 31; vs[t * 33 + d] = bf2f(MV[(grow0 + t) * 512 + h * 128 + db * 32 + d]); }
        if (F.wave == 0) { const int l = F.lane;
            const float ic = F.GATES()[(grow0 + l) * 16 + 8 + h] + bi; const float lf = logsigmoid_d(F.GATES()[(grow0 + l) * 16 + 12 + h] + bfg);
            float a = lf;
#pragma unroll
            for (int o = 1; o < 64; o <<= 1) { const float t = __shfl_up(a, o); if (l >= o) a += t; }
            const float g = __shfl(a, 63);
            float pm = ic - a;
#pragma unroll
            for (int o = 1; o < 64; o <<= 1) { const float t = __shfl_up(pm, o); if (l >= o) pm = fmaxf(pm, t); }
            const float mt = fmaxf(a + mstate, a + pm);
            const float wend = g - a + ic; float mw = wend;
#pragma unroll
            for (int o = 1; o < 64; o <<= 1) mw = fmaxf(mw, __shfl_xor(mw, o));
            const float mnew = fmaxf(g + mstate, mw);
            av[l] = a; icv[l] = ic; mtv[l] = mt; iwv[l] = __expf(a + mstate - mt); wtv[l] = __expf(wend - mnew);
            if (l == 0) scl[0] = __expf(g + mstate - mnew);
            mstate = mnew; }
        __syncthreads();
        { const int t = F.tid >> 3;
#pragma unroll 1
          for (int jj = 0; jj < 8; ++jj) { const int s = (F.tid & 7) + 8 * jj; float dot = 0.f;
#pragma unroll 4
              for (int e = 0; e < 128; ++e) dot += qs[t * 129 + e] * ks[s * 129 + e];
              Sm[t * 65 + s] = (s <= t) ? dot * __expf(av[t] - av[s] + icv[s] - mtv[t]) : 0.f; } }
        __syncthreads();
        if (F.tid < 64) { const int t = F.tid; float ds = 0.f, dn = 0.f;
            for (int s = 0; s < 64; ++s) ds += Sm[t * 65 + s];
            for (int e = 0; e < 128; ++e) dn += ns[e] * qs[t * 129 + e];
            denv[t] = ds + iwv[t] * dn; }
        __syncthreads();
#pragma unroll 1
        for (int n = 0; n < 4; ++n) { const int idx = F.tid + 512 * n, t = idx >> 5, d = idx & 31; float intra = 0.f, inter = 0.f;
#pragma unroll 4
            for (int s = 0; s < 64; ++s) intra += Sm[t * 65 + s] * vs[s * 33 + d];
#pragma unroll 4
            for (int e = 0; e < 128; ++e) inter += Cs[d * 129 + e] * qs[t * 129 + e];
            const float num = intra + iwv[t] * inter; const float den = fmaxf(fabsf(denv[t]), __expf(-mtv[t]));
            F.HB()[(grow0 + t) * 512 + h * 128 + db * 32 + d] = num / den; }
        __syncthreads();
        { const float decay = scl[0];
#pragma unroll 1
          for (int n = 0; n < 8; ++n) { const int idx = F.tid + 512 * n, d = idx >> 7, e = idx & 127; float acc = 0.f;
#pragma unroll 4
              for (int l = 0; l < 64; ++l) acc += wtv[l] * vs[l * 33 + d] * ks[l * 129 + e];
              Cs[d * 129 + e] = decay * Cs[d * 129 + e] + acc; }
          if (F.tid < 128) { const int e = F.tid; float acc = 0.f; for (int l = 0; l < 64; ++l) acc += wtv[l] * ks[l * 129 + e]; ns[e] = decay * ns[e] + acc; } }
        __syncthreads();
    }
}

#ifndef PHM
#define PHM 0x1fff
#endif
__global__ void __launch_bounds__(NWAVES * 64, 2) hymba_fwd(Args args) {
    extern __shared__ __attribute__((aligned(16))) unsigned char lds[];
    Frame F;
    F.lds = (LAS unsigned char*)lds;
    F.MISC = (volatile LAS unsigned*)(F.lds + MISC_OFF);
    F.tid = threadIdx.x; F.lane = F.tid & 63; F.wave = __builtin_amdgcn_readfirstlane(F.tid >> 6);
    F.G = gridDim.x; { const int bx = blockIdx.x; F.vcu = (F.G % 8 == 0) ? (bx % 8) * (F.G / 8) + bx / 8 : bx; }
    for (int u = F.tid; u < (LDS_BYTES - LDSCTL_OFF) / 4; u += NWAVES * 64) ((LAS unsigned*)(F.lds + LDSCTL_OFF))[u] = 0u;
    __syncthreads();
    XcdBarrier bar = xcd_barrier_post((unsigned*)(F.ctl() + CW_BAR), F.MISC + 8);
#define GRID_BAR() xcd_barrier(bar)

    if (PHM & 1) p0_prologue(F);
    GRID_BAR();
    if (PHM & 2) norm_mod_rows(F, F.x(), F.XN(), 0 * D, 1 * D);
    GRID_BAR();
    if (PHM & 4) { pg8::Gemm g{F.XN(), F.W1I_t(), M, 2 * FF, D}; pg8::StaticOrder S; S.init(M, 2 * FF, F.G, (int)blockIdx.x);
      pg8::EpiSwiglu E{F.ACT(), FF};
      pg8::gemm_phase<pg8::EpiSwiglu, pg8::StaticOrder, true, true>(F.lds + RING_OFF, g, S, E); }
    GRID_BAR();
    if (PHM & 8) { pg8::Gemm g{F.ACT(), F.W1O_t(), M, D, FF}; pg8::StaticOrder S; S.init(M, D, F.G, (int)blockIdx.x);
      pg8::EpiResGate E{F.x(), F.out(), D, F.MOD() + 2 * D, NMOD, SEQ, 0.5f};
      pg8::gemm_phase<pg8::EpiResGate, pg8::StaticOrder, true, true>(F.lds + RING_OFF, g, S, E); }
    GRID_BAR();
    if (PHM & 16) norm_mod_rows(F, F.out(), F.XN(), 3 * D, 4 * D);
    GRID_BAR();
    if (PHM & 32) { pg8::Gemm g{F.XN(), F.WMI_t(), M, MIXNP, D}; pg8::StaticOrder S; S.init(M, MIXNP, F.G, (int)blockIdx.x);
      pg8::EpiMix E{F.Y(), F.MIXB(), (size_t)M * 512, F.GATES(), QSCALE};
      pg8::gemm_phase<pg8::EpiMix, pg8::StaticOrder, true, true>(F.lds + RING_OFF, g, S, E); }
    GRID_BAR();
    if (PHM & 64) for (;;) {
        if (F.tid == 0) F.MISC[16] = __hip_atomic_fetch_add(F.ctl() + CW_QUEUE, 1u, RLX_AGENT);
        __syncthreads();
        const int idx = (int)F.MISC[16];
        __syncthreads();
        if (idx >= 64 + 512) break;
        if (idx < 64) mlstm_naive_unit(F, idx >> 4, (idx >> 2) & 3, idx & 3);
        else { const int a = idx - 64; attn_naive_unit(F, (a & 31) >> 3, a & 7, 15 - (a >> 5)); }
    }
    GRID_BAR();
    if (PHM & 128) mlstm_fixup_rows(F);
    GRID_BAR();
    if (PHM & 256) { pg8::Gemm g{F.Y(), F.WMO_t(), M, D, D}; pg8::StaticOrder S; S.init(M, D, F.G, (int)blockIdx.x);
      pg8::EpiResGate E{F.out(), F.out(), D, F.MOD() + 5 * D, NMOD, SEQ, 1.0f};
      pg8::gemm_phase<pg8::EpiResGate, pg8::StaticOrder, true, true>(F.lds + RING_OFF, g, S, E); }
    GRID_BAR();
    if (PHM & 512) norm_mod_rows(F, F.out(), F.XN(), 6 * D, 7 * D);
    GRID_BAR();
    if (PHM & 1024) { pg8::Gemm g{F.XN(), F.W2I_t(), M, 2 * FF, D}; pg8::StaticOrder S; S.init(M, 2 * FF, F.G, (int)blockIdx.x);
      pg8::EpiSwiglu E{F.ACT(), FF};
      pg8::gemm_phase<pg8::EpiSwiglu, pg8::StaticOrder, true, true>(F.lds + RING_OFF, g, S, E); }
    GRID_BAR();
    if (PHM & 2048) { pg8::Gemm g{F.ACT(), F.W2O_t(), M, D, FF}; pg8::StaticOrder S; S.init(M, D, F.G, (int)blockIdx.x);
      pg8::EpiResGate E{F.out(), F.out(), D, F.MOD() + 8 * D, NMOD, SEQ, 0.5f};
      pg8::gemm_phase<pg8::EpiResGate, pg8::StaticOrder, true, true>(F.lds + RING_OFF, g, S, E); }
    GRID_BAR();
    if (PHM & 4096) final_norm_rows(F, F.out());
}

extern "C" void kernel_launch(void* const* d_in, const int* in_sizes, int n_in, void* d_out, int out_size, void* d_ws, size_t ws_size, hipStream_t stream) {
    static int grid = 0;
    if (grid == 0) {
        if (n_in != 17 || in_sizes[0] != M * D || out_size != M * D || ws_size < WS_END) { fprintf(stderr, "kernel_launch: unexpected shapes (n_in %d, in0 %d, out %d, ws %zu); nothing launched\n", n_in, n_in > 0 ? in_sizes[0] : -1, out_size, ws_size); grid = -1; return; }
        int dev = 0, cus = 0, per_cu = 0;
        if (hipGetDevice(&dev) != hipSuccess || hipDeviceGetAttribute(&cus, hipDeviceAttributeMultiprocessorCount, dev) != hipSuccess) { fprintf(stderr, "kernel_launch: device query failed\n"); grid = -1; return; }
        if (hipFuncSetAttribute((const void*)hymba_fwd, hipFuncAttributeMaxDynamicSharedMemorySize, LDS_BYTES) != hipSuccess) { fprintf(stderr, "kernel_launch: hipFuncSetAttribute failed\n"); grid = -1; return; }
        if (hipOccupancyMaxActiveBlocksPerMultiprocessor(&per_cu, (const void*)hymba_fwd, NWAVES * 64, LDS_BYTES) != hipSuccess || per_cu < 1) { fprintf(stderr, "kernel_launch: occupancy query reports %d workgroups per CU; nothing launched\n", per_cu); (void)hipGetLastError(); grid = -1; return; }
        grid = cus;
    }
    if (grid < 0) return;
    if (hipMemsetAsync((char*)d_ws + WS_CTL, 0, CTL_ZERO_BYTES, stream) != hipSuccess) { fprintf(stderr, "kernel_launch: hipMemsetAsync failed\n"); return; }
    Args a{};
    for (int i = 0; i < 17; ++i) a.in[i] = (const float*)d_in[i];
    a.out = (float*)d_out; a.ws = (unsigned char*)d_ws;
    hipLaunchKernelGGL(hymba_fwd, dim3(grid), dim3(NWAVES * 64), LDS_BYTES, stream, a);
    const hipError_t le = hipPeekAtLastError();
    if (le != hipSuccess) fprintf(stderr, "kernel_launch: launch failed: %s\n", hipGetErrorName(le));
}
```

```cpp
#include <hip/hip_runtime.h>
#include <cstdio>
#include <cstdint>
namespace pg8 {
#define PG8_LAS __attribute__((address_space(3)))
typedef unsigned short bf16_t;
typedef short bf16x8 __attribute__((ext_vector_type(8)));
typedef float f32x4 __attribute__((ext_vector_type(4)));
typedef unsigned u32x4 __attribute__((ext_vector_type(4)));
constexpr int BM = 256, BK = 64, HALF = 128, HTB = HALF * BK * 2  , STAGE_BYTES = 8 * HTB, NXCD = 8, WGM = 8;

__host__ __device__ __forceinline__ int lds_byte(int r, int c) { const int st = (r >> 4) * 2 + (c >> 5), rr = r & 15, cc = c & 31, ob = rr * 64 + cc * 2; return st * 1024 + (ob ^ (((ob >> 9) & 1) << 5)); }
__host__ __device__ __forceinline__ void stage_rc(int b, int& R, int& C) { const int st = b / 1024, sb = b % 1024, swz = sb ^ (((sb >> 9) & 1) << 5); R = (st >> 1) * 16 + swz / 64; C = (st & 1) * 32 + (swz % 64) / 2; }
__host__ __device__ __forceinline__ int perm32(int rho) { const int n = rho >> 4, i = rho & 15; return 8 * (i >> 2) + 4 * n + (i & 3); }

struct Unit { int pm, pn; };
struct Gemm { const bf16_t* A; const bf16_t* Bt; int M, N, K; };

struct StaticOrder {
    int nM, nN, nwg, G, c;
    __host__ __device__ void init(int M, int N, int G_, int c_) { nM = M / BM; nN = N / BM; nwg = nM * nN; G = G_; c = c_; }
    __host__ __device__ bool next(int i, Unit& u) const {
        const long L = (long)i * G + c; if (L >= nwg) return false;
        int wgid = (int)L; { const int q = nwg / NXCD, r = nwg % NXCD, xcd = wgid % NXCD, off = wgid / NXCD; wgid = (xcd < r ? xcd * (q + 1) : r * (q + 1) + (xcd - r) * q) + off; }
        const int nig = WGM * nN, gid = wgid / nig, fm = gid * WGM, gsz = (nM - fm) < WGM ? (nM - fm) : WGM;
        u.pm = fm + ((wgid % nig) % gsz); u.pn = (wgid % nig) / gsz; return true;
    }
    __device__ __forceinline__ void a_ready(const Unit&) const {}
    __device__ __forceinline__ void done(const Unit&) const {}
};

__device__ __forceinline__ unsigned cvt_pk_bf16(float lo, float hi) { unsigned r; asm volatile("v_cvt_pk_bf16_f32 %0, %1, %2" : "=v"(r) : "v"(lo), "v"(hi)); return r; }
typedef float f32x2 __attribute__((ext_vector_type(2)));
__device__ __forceinline__ float silu_f(float g) { return g * __builtin_amdgcn_rcpf(1.0f + __builtin_amdgcn_exp2f(-1.4426950408889634f * g)); }

struct EpiSwiglu {
    static constexpr bool PERM = true, AFTER_DRAIN = false;
    bf16_t* O; int ldc;
    __device__ __forceinline__ void operator()(const f32x4 (&acc)[2][2][4][2], const Unit& u, int wr, int wc, int fr, int fq) const {
        const int row0 = u.pm * BM + wr * 64 + fr, col0 = u.pn * HALF + wc * 32 + 8 * fq;
#pragma unroll
        for (int ai = 0; ai < 2; ++ai)
#pragma unroll
            for (int m = 0; m < 4; ++m) { bf16_t* rowp = O + (size_t)(row0 + ai * HALF + m * 16) * ldc + col0;
                const f32x4 g0 = acc[ai][0][m][0], g1 = acc[ai][0][m][1], u0 = acc[ai][1][m][0], u1 = acc[ai][1][m][1];
                f32x4 v0, v1;
#pragma unroll
                for (int j = 0; j < 4; ++j) { v0[j] = silu_f(g0[j]) * u0[j]; v1[j] = silu_f(g1[j]) * u1[j]; }
                u32x4 w; w.x = cvt_pk_bf16(v0[0], v0[1]); w.y = cvt_pk_bf16(v0[2], v0[3]); w.z = cvt_pk_bf16(v1[0], v1[1]); w.w = cvt_pk_bf16(v1[2], v1[3]);
                *(u32x4*)rowp = w; }
    }
};

struct EpiResGate {
    static constexpr bool PERM = false, AFTER_DRAIN = false;
    const float* base; float* out; int ldc; const float* gate; int gstride; int rows_per_batch; float gs;
    __device__ __forceinline__ void operator()(const f32x4 (&acc)[2][2][4][2], const Unit& u, int wr, int wc, int fr, int fq) const {
        const int row0 = u.pm * BM + wr * 64 + fr, col0 = u.pn * BM + wc * 32 + 4 * fq;
        const float* gb = gate + (size_t)((u.pm * BM) / rows_per_batch) * gstride + col0;
        f32x4 gv[2][2];
#pragma unroll
        for (int bj = 0; bj < 2; ++bj)
#pragma unroll
            for (int n = 0; n < 2; ++n) gv[bj][n] = *(const f32x4*)(gb + bj * HALF + n * 16) * gs;
#pragma unroll
        for (int ai = 0; ai < 2; ++ai)
#pragma unroll
            for (int m = 0; m < 4; ++m) { const size_t off = (size_t)(row0 + ai * HALF + m * 16) * ldc + col0;
#pragma unroll
                for (int bj = 0; bj < 2; ++bj)
#pragma unroll
                    for (int n = 0; n < 2; ++n) { const f32x4 bs = *(const f32x4*)(base + off + bj * HALF + n * 16); *(f32x4*)(out + off + bj * HALF + n * 16) = bs + gv[bj][n] * acc[ai][bj][m][n]; } }
    }
};

struct EpiMix {
    static constexpr bool PERM = true, AFTER_DRAIN = false;
    bf16_t* Y; bf16_t* MIXB; size_t mix_stride; float* GATES; float qscale;
    __device__ __forceinline__ void operator()(const f32x4 (&acc)[2][2][4][2], const Unit& u, int wr, int wc, int fr, int fq) const {
        const int row0 = u.pm * BM + wr * 64 + fr;
        if (u.pn == 14) {
            if (wc == 0 && fq < 2) {
#pragma unroll
                for (int ai = 0; ai < 2; ++ai)
#pragma unroll
                    for (int m = 0; m < 4; ++m) { float* gp = GATES + (size_t)(row0 + ai * HALF + m * 16) * 16 + 8 * fq;
                        *(f32x4*)gp = acc[ai][0][m][0]; *(f32x4*)(gp + 4) = acc[ai][0][m][1]; }
            }
            return;
        }
        const int t = u.pn >> 1; const int col0 = (u.pn & 1) * BM + wc * 32 + 8 * fq;
        bf16_t* base; int ldc; float sc;
        if (t == 0) { base = Y; ldc = 1024; sc = qscale; } else { base = MIXB + (size_t)(t - 1) * mix_stride; ldc = 512; sc = 1.0f; }
#pragma unroll
        for (int ai = 0; ai < 2; ++ai)
#pragma unroll
            for (int m = 0; m < 4; ++m) { bf16_t* rowp = base + (size_t)(row0 + ai * HALF + m * 16) * ldc + col0;
#pragma unroll
                for (int bj = 0; bj < 2; ++bj) { const f32x4 v0 = acc[ai][bj][m][0] * sc, v1 = acc[ai][bj][m][1] * sc;
                    u32x4 w; w.x = cvt_pk_bf16(v0[0], v0[1]); w.y = cvt_pk_bf16(v0[2], v0[3]); w.z = cvt_pk_bf16(v1[0], v1[1]); w.w = cvt_pk_bf16(v1[2], v1[3]);
                    *(u32x4*)(rowp + bj * HALF) = w; } }
    }
};

template <class Epi, class Sched, bool ALIGN_EPI = false, bool SP2 = false>
__device__ __forceinline__ void gemm_phase(PG8_LAS unsigned char* lds, const Gemm g, const Sched& S, const Epi& E) {
    int tid_ = threadIdx.x; asm volatile("" : "+v"(tid_));
    const int tid = tid_, wid = __builtin_amdgcn_readfirstlane(tid >> 6), lane = tid & 63, wr = wid >> 2, wc = wid & 3, fr = lane & 15, fq = lane >> 4;
    const int K = g.K, nt = K / BK;
    unsigned voffA[2], voffB[2];
#pragma unroll
    for (int i = 0; i < 2; ++i) { int R, C; stage_rc(tid * 16 + i * 8192, R, C); const int Rb = Epi::PERM ? ((R & ~31) + perm32(R & 31)) : R;
        voffA[i] = (unsigned)(R * K + C) * 2u; voffB[i] = (unsigned)(Rb * K + C) * 2u; }
    const size_t kstep = (size_t)(BK * 2);
    const size_t hstep = (size_t)HALF * K * 2;
    const size_t tstep = 2 * hstep;
    const unsigned ldsw = (unsigned)wid * 1024u;
    const int aoff = lds_byte(wr * 64 + fr, fq * 8), boff = lds_byte(wc * 32 + fr, fq * 8);
#define PG8_SA(b, h) (((b) * 2 + (h)) * HTB)
#define PG8_SB(b, h) ((4 + (b) * 2 + (h)) * HTB)
#define PG8_STAGE(bufoff, gbase, voff) do { _Pragma("unroll") for (int _i = 0; _i < 2; ++_i) \
        __builtin_amdgcn_global_load_lds((const unsigned*)((const char*)(gbase) + (voff)[_i]), (PG8_LAS unsigned*)(lds + (bufoff) + ldsw + _i * 8192), 16, 0, 0); } while (0)
#define PG8_LDA(dst, b, h) do { _Pragma("unroll") for (int m = 0; m < 4; ++m) _Pragma("unroll") for (int k = 0; k < 2; ++k) dst[m][k] = *(const PG8_LAS bf16x8*)(lds + PG8_SA(b, h) + aoff + m * 2048 + k * 1024); } while (0)
#define PG8_LDB(dst, b, h) do { _Pragma("unroll") for (int n = 0; n < 2; ++n) _Pragma("unroll") for (int k = 0; k < 2; ++k) dst[n][k] = *(const PG8_LAS bf16x8*)(lds + PG8_SB(b, h) + boff + n * 2048 + k * 1024); } while (0)
#define PG8_MMA(ai, bj, At, Bt) do { __builtin_amdgcn_s_setprio(1); _Pragma("unroll") for (int m = 0; m < 4; ++m) _Pragma("unroll") for (int n = 0; n < 2; ++n) _Pragma("unroll") for (int k = 0; k < 2; ++k) \
        acc[ai][bj][m][n] = __builtin_amdgcn_mfma_f32_16x16x32_bf16(Bt[n][k], At[m][k], acc[ai][bj][m][n], 0, 0, 0); __builtin_amdgcn_s_setprio(0); } while (0)
#define PG8_WAIT_V(n) asm volatile("s_waitcnt vmcnt(" #n ")" ::: "memory")
#define PG8_WAIT_L(n) asm volatile("s_waitcnt lgkmcnt(" #n ")" ::: "memory")
#define PG8_BAR __builtin_amdgcn_s_barrier()
#define PG8_SCHED __builtin_amdgcn_sched_barrier(0)
    Unit cur, nxt; int ui = 0;
    if (!S.next(0, cur)) return;
    f32x4 acc[2][2][4][2];
#pragma unroll
    for (int a = 0; a < 2; ++a)
#pragma unroll
        for (int b = 0; b < 2; ++b)
#pragma unroll
            for (int m = 0; m < 4; ++m)
#pragma unroll
                for (int n = 0; n < 2; ++n) acc[a][b][m][n] = (f32x4){0.f, 0.f, 0.f, 0.f};
    bf16x8 At[4][2], B0[2][2], B1[2][2];
    const char* cA = (const char*)g.A + (size_t)cur.pm * tstep; const char* cB = (const char*)g.Bt + (size_t)cur.pn * tstep;
    S.a_ready(cur);
    if constexpr (SP2) {
        PG8_STAGE(PG8_SB(0, 0), cB, voffB); PG8_STAGE(PG8_SB(0, 1), cB + hstep, voffB); PG8_STAGE(PG8_SA(0, 0), cA, voffA); PG8_STAGE(PG8_SA(0, 1), cA + hstep, voffA);
        if (wr == 1) PG8_BAR;
        PG8_WAIT_V(2); PG8_BAR;
        PG8_STAGE(PG8_SB(1, 0), cB + kstep, voffB); PG8_STAGE(PG8_SA(1, 0), cA + kstep, voffA); PG8_STAGE(PG8_SB(1, 1), cB + hstep + kstep, voffB);
        PG8_WAIT_V(6); PG8_BAR;
    } else {
        PG8_STAGE(PG8_SB(0, 0), cB, voffB); PG8_STAGE(PG8_SA(0, 0), cA, voffA); PG8_STAGE(PG8_SB(0, 1), cB + hstep, voffB); PG8_STAGE(PG8_SA(0, 1), cA + hstep, voffA);
        if (wr == 1) PG8_BAR;
        PG8_WAIT_V(4); PG8_BAR;
        PG8_STAGE(PG8_SB(1, 0), cB + kstep, voffB); PG8_STAGE(PG8_SA(1, 0), cA + kstep, voffA); PG8_STAGE(PG8_SB(1, 1), cB + hstep + kstep, voffB);
        PG8_WAIT_V(6); PG8_BAR;
    }
    for (;;) {
        const bool has_next = S.next(ui + 1, nxt);
        const char* nA = has_next ? (const char*)g.A + (size_t)nxt.pm * tstep : cA; const char* nB = has_next ? (const char*)g.Bt + (size_t)nxt.pn * tstep : cB;
        for (int t = 0; t < nt; t += 2) {
            const bool last = (t == nt - 2);
            const char* a1 = cA + (size_t)(t + 1) * kstep;
            const char* a2 = last ? nA : cA + (size_t)(t + 2) * kstep; const char* b2 = last ? nB : cB + (size_t)(t + 2) * kstep;
            const char* a3 = a2 + kstep; const char* b3 = b2 + kstep;
            if (last && has_next) S.a_ready(nxt);
            if constexpr (SP2) {
            PG8_LDB(B0, 0, 0); PG8_LDB(B1, 0, 1); PG8_SCHED; PG8_LDA(At, 0, 0); PG8_STAGE(PG8_SA(1, 1), a1 + hstep, voffA);
            PG8_WAIT_V(8); PG8_WAIT_L(0); PG8_BAR; PG8_MMA(0, 0, At, B0); PG8_MMA(0, 1, At, B1); PG8_BAR; PG8_SCHED;
            PG8_LDA(At, 0, 1); PG8_STAGE(PG8_SB(0, 0), b2, voffB); PG8_STAGE(PG8_SB(0, 1), b2 + hstep, voffB); PG8_STAGE(PG8_SA(0, 0), a2, voffA);
            PG8_WAIT_V(8); PG8_WAIT_L(0); PG8_BAR; PG8_MMA(1, 0, At, B0); PG8_MMA(1, 1, At, B1); PG8_BAR; PG8_SCHED;
            PG8_LDB(B0, 1, 0); PG8_LDB(B1, 1, 1); PG8_SCHED; PG8_LDA(At, 1, 0); PG8_STAGE(PG8_SA(0, 1), a2 + hstep, voffA);
            PG8_WAIT_V(8); PG8_WAIT_L(0); PG8_BAR; PG8_MMA(0, 0, At, B0); PG8_MMA(0, 1, At, B1); PG8_BAR; PG8_SCHED;
            PG8_LDA(At, 1, 1); PG8_STAGE(PG8_SB(1, 0), b3, voffB); PG8_STAGE(PG8_SB(1, 1), b3 + hstep, voffB); PG8_STAGE(PG8_SA(1, 0), a3, voffA);
            PG8_WAIT_V(8); PG8_WAIT_L(0); PG8_BAR; PG8_MMA(1, 0, At, B0); PG8_MMA(1, 1, At, B1); PG8_BAR; PG8_SCHED;
            } else {
            PG8_LDB(B0, 0, 0); PG8_SCHED; PG8_LDA(At, 0, 0); PG8_STAGE(PG8_SA(1, 1), a1 + hstep, voffA);
            PG8_WAIT_L(8); PG8_BAR; PG8_WAIT_L(0); PG8_MMA(0, 0, At, B0); PG8_BAR; PG8_SCHED;
            PG8_LDB(B1, 0, 1); PG8_STAGE(PG8_SB(0, 0), b2, voffB);
            PG8_BAR; PG8_WAIT_L(0); PG8_MMA(0, 1, At, B1); PG8_BAR;
            PG8_LDA(At, 0, 1); PG8_STAGE(PG8_SA(0, 0), a2, voffA);
            PG8_BAR; PG8_WAIT_L(0); PG8_MMA(1, 0, At, B0); PG8_BAR; PG8_SCHED;
            PG8_STAGE(PG8_SB(0, 1), b2 + hstep, voffB);
            PG8_WAIT_V(6); PG8_BAR; PG8_MMA(1, 1, At, B1); PG8_BAR;
            PG8_LDB(B0, 1, 0); PG8_SCHED; PG8_LDA(At, 1, 0); PG8_STAGE(PG8_SA(0, 1), a2 + hstep, voffA);
            PG8_WAIT_L(8); PG8_BAR; PG8_WAIT_L(0); PG8_MMA(0, 0, At, B0); PG8_BAR; PG8_SCHED;
            PG8_LDB(B1, 1, 1); PG8_STAGE(PG8_SB(1, 0), b3, voffB);
            PG8_BAR; PG8_WAIT_L(0); PG8_MMA(0, 1, At, B1); PG8_BAR;
            PG8_LDA(At, 1, 1); PG8_STAGE(PG8_SA(1, 0), a3, voffA);
            PG8_BAR; PG8_WAIT_L(0); PG8_MMA(1, 0, At, B0); PG8_BAR; PG8_SCHED;
            PG8_STAGE(PG8_SB(1, 1), b3 + hstep, voffB);
            PG8_WAIT_V(6); PG8_BAR; PG8_MMA(1, 1, At, B1); PG8_BAR;
            }
        }
        if constexpr (ALIGN_EPI) { if (wr == 0) PG8_BAR; }
        if constexpr (!Epi::AFTER_DRAIN) { E(acc, cur, wr, wc, fr, fq); S.done(cur); }
        if (!has_next) break;
#pragma unroll
        for (int a = 0; a < 2; ++a)
#pragma unroll
            for (int b = 0; b < 2; ++b)
#pragma unroll
                for (int m = 0; m < 4; ++m)
#pragma unroll
                    for (int n = 0; n < 2; ++n) acc[a][b][m][n] = (f32x4){0.f, 0.f, 0.f, 0.f};
        cur = nxt; cA = nA; cB = nB; ++ui;
        if constexpr (ALIGN_EPI) { if (wr == 1) PG8_BAR; }
    }
    PG8_WAIT_V(0);
    if constexpr (!ALIGN_EPI) { if (wr == 0) PG8_BAR; }
    PG8_BAR;
    if constexpr (Epi::AFTER_DRAIN) { E.fused(acc, cur, wr, wc, fr, fq, lds, wid, lane); S.done(cur); }
#undef PG8_SA
#undef PG8_SB
#undef PG8_STAGE
#undef PG8_LDA
#undef PG8_LDB
#undef PG8_MMA
#undef PG8_WAIT_V
#undef PG8_WAIT_L
#undef PG8_BAR
#undef PG8_SCHED
}
}
constexpr int NWAVES = 8;
constexpr int BATCH = 4, SEQ = 4096, D = 1024, FF = 2816, NMOD = 9 * D;
constexpr int M = BATCH * SEQ;
constexpr int MIXN = 3600;
constexpr int MIXNP = 3840;
constexpr float EPS = 1e-6f;
constexpr float QSCALE = 0.125f * 1.4426950408889634f;

constexpr size_t MiB = 1u << 20;
constexpr size_t WS_CTL = 0, CTL_ZERO_BYTES = 1 * MiB;
constexpr size_t WS_MOD = 1 * MiB, WS_GATES = 2 * MiB;
constexpr size_t WS_W1I = 4 * MiB, WS_W1O = 15 * MiB, WS_WMI = 21 * MiB, WS_WMO = 29 * MiB, WS_W2I = 31 * MiB, WS_W2O = 42 * MiB;
constexpr size_t WS_XN = 48 * MiB;
constexpr size_t WS_Y = 80 * MiB;
constexpr size_t WS_ACT = 112 * MiB;
constexpr size_t WS_QC = 208 * MiB, WS_KC = 224 * MiB;
constexpr size_t WS_MS = 240 * MiB, WS_DEC = 242 * MiB, WS_CB = 3 * MiB;
constexpr size_t WS_END = 243 * MiB;
static_assert(WS_W1I + (size_t)2 * FF * D * 2 <= WS_W1O && WS_W1O + (size_t)D * FF * 2 <= WS_WMI && WS_WMI + (size_t)MIXNP * D * 2 <= WS_WMO && WS_WMO + (size_t)D * D * 2 <= WS_W2I &&
              WS_W2I + (size_t)2 * FF * D * 2 <= WS_W2O && WS_W2O + (size_t)D * FF * 2 <= WS_XN && WS_XN + (size_t)M * D * 2 <= WS_Y && WS_Y + (size_t)M * D * 2 <= WS_ACT &&
              WS_ACT + (size_t)6 * M * 512 * 2 <= WS_QC && WS_ACT + (size_t)M * FF * 2 <= WS_QC && WS_MS + (size_t)16 * 5 * SEQ * 4 <= WS_DEC && WS_CB + (size_t)32 * SEQ * 4 <= WS_W1I && WS_MOD + (size_t)BATCH * NMOD * 4 <= WS_GATES && WS_GATES + (size_t)M * 16 * 4 <= WS_W1I, "d_ws map");
constexpr int CW_QUEUE = 64;
constexpr int CW_BAR = 4096;

constexpr int RING_OFF = 0, RING_BYTES = 131072;
constexpr int LDSCTL_OFF = RING_BYTES, MISC_OFF = LDSCTL_OFF + 320;
constexpr int LDS_BYTES = 147456;
static_assert(MISC_OFF + 128 <= LDS_BYTES, "LDS map");

#include <hip/hip_bf16.h>
#include <cmath>
namespace attn_body {
using bf16=__hip_bfloat16;
using bf16x8=__attribute__((ext_vector_type(8)))short;
using s16x4=__attribute__((ext_vector_type(4)))short;
using f32x16=__attribute__((ext_vector_type(16)))float;
using u32x4=__attribute__((ext_vector_type(4)))unsigned;
constexpr int BATCH=4,NHEAD=8,SEQ=4096,D=64,DM=1024,DKV=512;
constexpr int NW=8,QBLK=32,QB=QBLK*NW,KVBLK=64,NQB=SEQ/QB;
constexpr int ATTN_UNIT_ROWS=QB;
__device__ __forceinline__ int crow(int r,int hi){return (r&3)+8*(r>>2)+4*hi;}
#define SBAR() __builtin_amdgcn_sched_barrier(0)
__device__ __forceinline__ void cmask(f32x16&p0,f32x16&p1,int jb,int qrel,int hi){
  const float NEG=-INFINITY; int kb=64*jb+4*hi;
  #pragma unroll
  for(int r=0;r<16;++r){int kv=kb+(r&3)+8*(r>>2); if(kv>qrel)p0[r]=NEG; if(kv+32>qrel)p1[r]=NEG;}
}

constexpr int NSLOT=3, SLOTB=8192;
constexpr int LDS_K=0, LDS_V=NSLOT*SLOTB, LDS_WS=2*NSLOT*SLOTB, LDS_OST=LDS_WS+NW*64*4, LDS_BYTES=LDS_OST+NW*4096;
constexpr float C2=0.125f*1.4426950408889634f;
__device__ __forceinline__ void glds16(const void*gsrc,unsigned lds_dst){unsigned keep;
  asm volatile("s_mov_b32 %0, m0\n\ts_mov_b32 m0, %2\n\ts_nop 0\n\tglobal_load_lds_dwordx4 %1, off\n\ts_mov_b32 m0, %0":"=&s"(keep):"v"(gsrc),"s"(lds_dst):"memory");}
__device__ __forceinline__ float max3f(float a,float b,float c){float r;asm("v_max3_f32 %0, %1, %2, %3":"=v"(r):"v"(a),"v"(b),"v"(c));return r;}
__device__ __forceinline__ float max2f(float a,float b){float r;asm("v_max_f32_e32 %0, %1, %2":"=v"(r):"v"(a),"v"(b));return r;}
__device__ __forceinline__ float fadd_s(float a,float b){float r;asm("v_add_f32_e32 %0, %1, %2":"=v"(r):"v"(a),"v"(b));return r;}
__device__ __forceinline__ float fsub_s(float a,float b){float r;asm("v_sub_f32_e32 %0, %1, %2":"=v"(r):"v"(a),"v"(b));return r;}
typedef float f32x2_t __attribute__((ext_vector_type(2))); typedef __bf16 bf16x2_t __attribute__((ext_vector_type(2)));
__device__ __forceinline__ unsigned cvtpk_s(float lo,float hi){f32x2_t v={lo,hi};bf16x2_t b=__builtin_convertvector(v,bf16x2_t);return __builtin_bit_cast(unsigned,b);}
#define WAIT_BAR(N) asm volatile("s_waitcnt vmcnt(" #N ") lgkmcnt(0)\n\ts_barrier":::"memory")

__device__ __forceinline__ void qkt(f32x16&p0,f32x16&p1,const char*Kslot,const bf16x8*qr,int r32,int hi){
  const char*kb=Kslot+hi*1024+r32*16;
  #pragma unroll
  for(int d0=0;d0<4;++d0){
    const bf16x8 b0=*reinterpret_cast<const bf16x8*>(kb+d0*2048);
    const bf16x8 b1=*reinterpret_cast<const bf16x8*>(kb+d0*2048+512);
    {p0=__builtin_amdgcn_mfma_f32_32x32x16_bf16(b0,qr[d0],p0,0,0,0);p1=__builtin_amdgcn_mfma_f32_32x32x16_bf16(b1,qr[d0],p1,0,0,0);}}
}
typedef __attribute__((address_space(3))) const char* lds_cptr;
typedef short v4i16_t __attribute__((ext_vector_type(4)));
__device__ __forceinline__ void kload8(bf16x8*kf,lds_cptr kp){
  kf[0]=*(const __attribute__((address_space(3))) bf16x8*)(kp);      kf[1]=*(const __attribute__((address_space(3))) bf16x8*)(kp+512);
  kf[2]=*(const __attribute__((address_space(3))) bf16x8*)(kp+2048); kf[3]=*(const __attribute__((address_space(3))) bf16x8*)(kp+2560);
  kf[4]=*(const __attribute__((address_space(3))) bf16x8*)(kp+4096); kf[5]=*(const __attribute__((address_space(3))) bf16x8*)(kp+4608);
  kf[6]=*(const __attribute__((address_space(3))) bf16x8*)(kp+6144); kf[7]=*(const __attribute__((address_space(3))) bf16x8*)(kp+6656);
}
__device__ __forceinline__ void kload2(bf16x8*kf,lds_cptr kp,int j){ kf[2*j]=*(const __attribute__((address_space(3))) bf16x8*)(kp+j*2048); kf[2*j+1]=*(const __attribute__((address_space(3))) bf16x8*)(kp+j*2048+512); }
__device__ __forceinline__ s16x4 vtr(lds_cptr p){ return __builtin_bit_cast(s16x4,__builtin_amdgcn_ds_read_tr16_b64_v4i16((__attribute__((address_space(3))) v4i16_t*)p)); }
__device__ __forceinline__ float rowmax(const f32x16&p0,const f32x16&p1){
  float a=max3f(p0[0],p0[1],p1[0]),b=max3f(p0[2],p0[3],p1[1]);a=max3f(a,p1[2],p1[3]);
  #pragma unroll
  for(int r=4;r<16;r+=4){a=max3f(a,p0[r],p0[r+1]);b=max3f(b,p0[r+2],p0[r+3]);a=max3f(a,p1[r],p1[r+1]);b=max3f(b,p1[r+2],p1[r+3]);}
  const float m=max2f(a,b);
  auto rr=__builtin_amdgcn_permlane32_swap(__float_as_uint(m),__float_as_uint(m),false,false);
  return max2f(__uint_as_float(rr[0]),__uint_as_float(rr[1]));
}
__device__ __forceinline__ void pv(f32x16*o,int vb,bf16x8 pa0,bf16x8 pa1,bf16x8 pa2,bf16x8 pa3){
  #pragma unroll
  for(int d0=0;d0<2;++d0){s16x4 lo[4],hi[4];
    #pragma unroll
    for(int ks=0;ks<4;++ks){
      asm volatile("ds_read_b64_tr_b16 %0,%1 offset:%c2":"=&v"(lo[ks]):"v"(vb),"i"(d0*4096+ks*1024):"memory");
      asm volatile("ds_read_b64_tr_b16 %0,%1 offset:%c2":"=&v"(hi[ks]):"v"(vb),"i"(d0*4096+ks*1024+512):"memory");}
    asm volatile("s_waitcnt lgkmcnt(0)":::"memory");SBAR();
    #define PK(k) (bf16x8){lo[k][0],lo[k][1],lo[k][2],lo[k][3],hi[k][0],hi[k][1],hi[k][2],hi[k][3]}
    o[d0]=__builtin_amdgcn_mfma_f32_32x32x16_bf16(pa0,PK(0),o[d0],0,0,0);
    o[d0]=__builtin_amdgcn_mfma_f32_32x32x16_bf16(pa1,PK(1),o[d0],0,0,0);
    o[d0]=__builtin_amdgcn_mfma_f32_32x32x16_bf16(pa2,PK(2),o[d0],0,0,0);
    o[d0]=__builtin_amdgcn_mfma_f32_32x32x16_bf16(pa3,PK(3),o[d0],0,0,0);
    #undef PK
  }
}

#ifndef ATTN_STORE16
#define ATTN_STORE16(p,v) (*(u32x4*)(p)=(v))
#endif
typedef __attribute__((address_space(3))) const float* lds_fptr;
typedef float f32x4_t __attribute__((ext_vector_type(4)));
#define LDF4(p) (*(const __attribute__((address_space(3))) f32x4_t*)(p))
#define CINIT(C0,C1,t) do{ const lds_fptr cbt_=cbl+(t)*64+4*hi; const float nmh_=-mhat; \
    { const f32x4_t a0_=LDF4(cbt_),a1_=LDF4(cbt_+8),a2_=LDF4(cbt_+16),a3_=LDF4(cbt_+24); \
      C0=__builtin_shufflevector(__builtin_shufflevector(a0_,a1_,0,1,2,3,4,5,6,7),__builtin_shufflevector(a2_,a3_,0,1,2,3,4,5,6,7),0,1,2,3,4,5,6,7,8,9,10,11,12,13,14,15); } \
    { const f32x4_t a0_=LDF4(cbt_+32),a1_=LDF4(cbt_+40),a2_=LDF4(cbt_+48),a3_=LDF4(cbt_+56); \
      C1=__builtin_shufflevector(__builtin_shufflevector(a0_,a1_,0,1,2,3,4,5,6,7),__builtin_shufflevector(a2_,a3_,0,1,2,3,4,5,6,7),0,1,2,3,4,5,6,7,8,9,10,11,12,13,14,15); } \
    C0=nmh_-C0; C1=nmh_-C1; }while(0)
template<int THRL> __device__ __forceinline__ void attn_unit(int b,int h,int qb,const bf16*Q,const bf16*__restrict__ K,const bf16*__restrict__ V,bf16*O,char*shm,lds_fptr cbl){
  int tid_=threadIdx.x; asm volatile("":"+v"(tid_)); const int tid=tid_,lane=tid&63,r32=lane&31,hi=lane>>5; const int wid=__builtin_amdgcn_readfirstlane(tid>>6);
  const long rowbase=(long)b*SEQ; const int q0=qb*QB;
  const bf16*Qw=Q+(rowbase+q0+wid*QBLK)*DM+h*D;
  const bf16*Kh=K+rowbase*DKV+h*D,*Vh=V+rowbase*DKV+h*D;
  const unsigned lds0=(unsigned)(uintptr_t)shm;
  float*wsf=(float*)(shm+LDS_WS)+wid*64;
  const bf16*ksrc=Kh+(long)lane*DKV+wid*8;
  const bf16*vsrc=Vh+(long)(16*(wid&3)+(lane>>2))*DKV+(wid>>2)*32+(lane&3)*8;
  const unsigned kdst=lds0+LDS_K+wid*1024, vdst=lds0+LDS_V+wid*1024;
  #define DMA_K(t,slot) glds16(ksrc+(long)(t)*KVBLK*DKV,(unsigned)__builtin_amdgcn_readfirstlane(kdst+(slot)))
  #define DMA_V(t,slot) glds16(vsrc+(long)(t)*KVBLK*DKV,(unsigned)__builtin_amdgcn_readfirstlane(vdst+(slot)))
  const int vb0=(int)(lds0+LDS_V)+((lane>>4)&1)*32+(lane&3)*8+(4*hi+((lane&15)>>2))*64;
  const char*Kbase=shm+LDS_K; bf16x8 kf[8];
  const lds_cptr shm3=(lds_cptr)shm; const lds_cptr kp0=shm3+LDS_K+hi*1024+r32*16; const lds_cptr vp0=shm3+LDS_V+((lane>>4)&1)*32+(lane&3)*8+(4*hi+((lane&15)>>2))*64;
  const int NT=(q0+QB)/KVBLK;
  DMA_K(0,0);DMA_V(0,0);DMA_K(1,SLOTB);
  bf16x8 qr[4];
  #pragma unroll
  for(int d0=0;d0<4;++d0)qr[d0]=*reinterpret_cast<const bf16x8*>(&Qw[(long)r32*DM+d0*16+hi*8]);
  float mhat=0.f,l_reg=0.f;f32x16 o[2];o[0]=f32x16{};o[1]=f32x16{};
  const int qrel=wid*QBLK+r32;
  #define CMASK(P0,P1,t) do{int jb_=(t)-(NT-4); if(jb_>=0)cmask(P0,P1,jb_,qrel,hi);}while(0)
  bool resc=false;
  #define START(P0,P1) do{ const float rm=rowmax(P0,P1); resc=false; \
    { const float dl=rm; mhat=fadd_s(mhat,dl); \
      _Pragma("unroll") for(int r=0;r<16;++r){P0[r]=fsub_s(P0[r],dl);P1[r]=fsub_s(P1[r],dl);} \
      } \
    _Pragma("unroll") for(int r=0;r<16;++r)P0[r]=__builtin_amdgcn_exp2f(P0[r]); }while(0)
  #define RESC() do{ if(resc){ asm volatile("s_waitcnt lgkmcnt(0)":::"memory"); \
      _Pragma("unroll") for(int d_=0;d_<2;++d_) _Pragma("unroll") for(int r=0;r<16;++r)o[d_][r]*=wsf[crow(r,hi)]; } }while(0)
  f32x16 pA0,pA1,pB0,pB1;
  int sl_prev=0,sl_cur=0,sl_next=SLOTB;
  #define ROT() do{sl_prev=sl_cur;sl_cur=sl_next;sl_next=(sl_next==(NSLOT-1)*SLOTB)?0:sl_next+SLOTB;}while(0)
  DMA_K(2,2*SLOTB);
  WAIT_BAR(3);
  CINIT(pA0,pA1,0); qkt(pA0,pA1,Kbase,qr,r32,hi);asm volatile("s_nop 15\n\ts_nop 7":"+v"(pA0),"+v"(pA1));CMASK(pA0,pA1,0);
  START(pA0,pA1);
  _Pragma("unroll") for(int r=0;r<16;++r)pA1[r]=__builtin_amdgcn_exp2f(pA1[r]);
  WAIT_BAR(0);
  DMA_K(3,0);DMA_V(1,SLOTB);
  ROT();
  kload8(kf,kp0+sl_cur);
  WAIT_BAR(2);
  s16x4 vlo[8],vhi[8]; u32x4 pw0,pw1,pw2,pw3;
  #define PKW(P,B) cvtpk_s(P[B],P[B+1])
  #define PAF(k) __builtin_bit_cast(bf16x8,pw##k)
  #define VFR(i) (bf16x8){vlo[i][0],vlo[i][1],vlo[i][2],vlo[i][3],vhi[i][0],vhi[i][1],vhi[i][2],vhi[i][3]}
  #define PIN(x) asm volatile("":"+v"(x))
  #define MX3(a,b,c) __builtin_fmaxf(__builtin_fmaxf((a),(b)),(c))
  #define GAPA(MF,A0,A1,A2,A3,W0,W1,PW) do{ MF; sacc+=A0; sacc+=A1; sacc+=A2; sacc+=A3; PIN(sacc); W0; W1; PIN(PW); SBAR(); }while(0)
  #define EX(v) __builtin_amdgcn_exp2f(v)
  #define GAPB(MF,X,B) do{ MF; X[B]=EX(X[B]); X[B+1]=EX(X[B+1]); X[B+2]=EX(X[B+2]); X[B+3]=EX(X[B+3]); PIN(X); SBAR(); }while(0)
  #define VRD(i) do{ vlo[i]=vtr(vp_+(((i)>>2)*4096+((i)&3)*1024)); vhi[i]=vtr(vp_+(((i)>>2)*4096+((i)&3)*1024+512)); }while(0)
  #define KRD(G,j) do{ if(G){ kload2(kf,kp0+sl_next,j); SBAR(); } }while(0)
  #define STEP(C0,C1,P0,P1,t,GK,GV,GL) do{ SBAR(); \
    CINIT(C0,C1,t); SBAR(); \
    const lds_cptr vp_=vp0+sl_prev; \
    VRD(0); SBAR(); float sacc=(P0[0]+P0[1]); \
    GAPA(C0=__builtin_amdgcn_mfma_f32_32x32x16_bf16(kf[0],qr[0],C0,0,0,0), P0[2],P0[3],P0[4],P0[5],     pw0[0]=PKW(P0,0), pw0[1]=PKW(P0,2), pw0); \
    VRD(4); SBAR(); GAPA(C1=__builtin_amdgcn_mfma_f32_32x32x16_bf16(kf[1],qr[0],C1,0,0,0), P0[6],P0[7],P0[8],P0[9],     pw0[2]=PKW(P0,4), pw0[3]=PKW(P0,6), pw0); \
    VRD(1); SBAR(); GAPA(C0=__builtin_amdgcn_mfma_f32_32x32x16_bf16(kf[2],qr[1],C0,0,0,0),   P0[10],P0[11],P0[12],P0[13], pw1[0]=PKW(P0,8), pw1[1]=PKW(P0,10), pw1); \
    VRD(5); SBAR(); GAPA(C1=__builtin_amdgcn_mfma_f32_32x32x16_bf16(kf[3],qr[1],C1,0,0,0),   P0[14],P0[15],P1[0],P1[1],   pw1[2]=PKW(P0,12),pw1[3]=PKW(P0,14), pw1); \
    VRD(2); SBAR(); GAPA(C0=__builtin_amdgcn_mfma_f32_32x32x16_bf16(kf[4],qr[2],C0,0,0,0),   P1[2],P1[3],P1[4],P1[5],     pw2[0]=PKW(P1,0), pw2[1]=PKW(P1,2), pw2); \
    VRD(6); SBAR(); GAPA(C1=__builtin_amdgcn_mfma_f32_32x32x16_bf16(kf[5],qr[2],C1,0,0,0),   P1[6],P1[7],P1[8],P1[9],     pw2[2]=PKW(P1,4), pw2[3]=PKW(P1,6), pw2); \
    VRD(3); SBAR(); GAPA(C0=__builtin_amdgcn_mfma_f32_32x32x16_bf16(kf[6],qr[3],C0,0,0,0),   P1[10],P1[11],P1[12],P1[13], pw3[0]=PKW(P1,8), pw3[1]=PKW(P1,10), pw3); \
    VRD(7); SBAR(); GAPA(C1=__builtin_amdgcn_mfma_f32_32x32x16_bf16(kf[7],qr[3],C1,0,0,0),   P1[14],P1[15],0.f,0.f,       pw3[2]=PKW(P1,12),pw3[3]=PKW(P1,14), pw3); \
    l_reg+=sacc; \
    if(GK){DMA_K((t)+3,sl_cur);} if(GV){DMA_V((t)+1,sl_next);} \
    CMASK(C0,C1,t); \
    { float a=MX3(C0[0],C0[1],C1[0]),b=MX3(C0[2],C0[3],C1[1]); a=MX3(a,C1[2],C1[3]); \
      _Pragma("unroll") for(int r=4;r<16;r+=4){a=MX3(a,C0[r],C0[r+1]);b=MX3(b,C0[r+2],C0[r+3]);a=MX3(a,C1[r],C1[r+1]);b=MX3(b,C1[r+2],C1[r+3]);} \
      float rm=__builtin_fmaxf(a,b); { auto rr=__builtin_amdgcn_permlane32_swap(__float_as_uint(rm),__float_as_uint(rm),false,false); rm=__builtin_fmaxf(__uint_as_float(rr[0]),__uint_as_float(rr[1])); } \
      resc=false; \
      if(__builtin_expect(__any(rm>(float)THRL),0)){ const float dl=__builtin_fmaxf(rm,0.f); mhat+=dl; \
        _Pragma("unroll") for(int r=0;r<16;++r){C0[r]-=dl;C1[r]-=dl;} \
        const float f=__builtin_amdgcn_exp2f(-dl); l_reg*=f; if(hi==0)wsf[r32]=f; resc=true; } } \
    SBAR(); \
    GAPB(o[0]=__builtin_amdgcn_mfma_f32_32x32x16_bf16(PAF(0),VFR(0),o[0],0,0,0), C0,0); \
    GAPB(o[1]=__builtin_amdgcn_mfma_f32_32x32x16_bf16(PAF(0),VFR(4),o[1],0,0,0), C0,4); \
    KRD(GL,0); GAPB(o[0]=__builtin_amdgcn_mfma_f32_32x32x16_bf16(PAF(1),VFR(1),o[0],0,0,0), C0,8); \
    KRD(GL,1); GAPB(o[1]=__builtin_amdgcn_mfma_f32_32x32x16_bf16(PAF(1),VFR(5),o[1],0,0,0), C0,12); \
    KRD(GL,2); GAPB(o[0]=__builtin_amdgcn_mfma_f32_32x32x16_bf16(PAF(2),VFR(2),o[0],0,0,0), C1,0); \
    KRD(GL,3); GAPB(o[1]=__builtin_amdgcn_mfma_f32_32x32x16_bf16(PAF(2),VFR(6),o[1],0,0,0), C1,4); \
    GAPB(o[0]=__builtin_amdgcn_mfma_f32_32x32x16_bf16(PAF(3),VFR(3),o[0],0,0,0), C1,8); \
    GAPB(o[1]=__builtin_amdgcn_mfma_f32_32x32x16_bf16(PAF(3),VFR(7),o[1],0,0,0), C1,12); \
    }while(0)
  int t=1;
  #undef CMASK
  #define CMASK(P0,P1,t) do{}while(0)
  for(;t+5<NT;t+=2){
    STEP(pB0,pB1,pA0,pA1,t,true,true,true);     WAIT_BAR(2); RESC(); ROT();
    STEP(pA0,pA1,pB0,pB1,t+1,true,true,true);   WAIT_BAR(2); RESC(); ROT();
  }
  #undef CMASK
  #define CMASK(P0,P1,t) do{int jb_=(t)-(NT-4); if(jb_>=0)cmask(P0,P1,jb_,qrel,hi);}while(0)
  #define ENDW(tt) do{ if((tt)+3<NT){WAIT_BAR(2);} else if((tt)+2<NT){WAIT_BAR(1);} else {WAIT_BAR(0);} }while(0)
  for(;t+1<NT;t+=2){
    STEP(pB0,pB1,pA0,pA1,t,(t+3<NT),(t+1<NT),(t+1<NT));       ENDW(t);   RESC(); ROT();
    STEP(pA0,pA1,pB0,pB1,t+1,(t+4<NT),(t+2<NT),(t+2<NT));     ENDW(t+1); RESC(); ROT();
  }
  STEP(pB0,pB1,pA0,pA1,NT-1,false,false,false); RESC();
  { float sacc=pB0[0]+pB0[1]; _Pragma("unroll") for(int r=2;r<16;++r)sacc+=pB0[r]; _Pragma("unroll") for(int r=0;r<16;++r)sacc+=pB1[r]; l_reg+=sacc;
    pw0=(u32x4){PKW(pB0,0),PKW(pB0,2),PKW(pB0,4),PKW(pB0,6)};pw1=(u32x4){PKW(pB0,8),PKW(pB0,10),PKW(pB0,12),PKW(pB0,14)};pw2=(u32x4){PKW(pB1,0),PKW(pB1,2),PKW(pB1,4),PKW(pB1,6)};pw3=(u32x4){PKW(pB1,8),PKW(pB1,10),PKW(pB1,12),PKW(pB1,14)};
    SBAR(); pv(o,vb0+sl_cur,PAF(0),PAF(1),PAF(2),PAF(3)); }
  #undef PKW
  #undef PAF
  #undef VFR
  #undef PIN
  #undef MX3
  #undef GAPA
  #undef GAPB
  #undef EX
  #undef VRD
  #undef KRD
  #undef STEP
  #undef ENDW
  {auto rr=__builtin_amdgcn_permlane32_swap(__float_as_uint(l_reg),__float_as_uint(l_reg),false,false);l_reg=__uint_as_float(rr[0])+__uint_as_float(rr[1]);}
  if(hi==0)wsf[32+r32]=l_reg;asm volatile("s_waitcnt lgkmcnt(0)":::"memory");
  float rli[16];
  #pragma unroll
  for(int r=0;r<16;++r)rli[r]=__builtin_amdgcn_rcpf(wsf[32+crow(r,hi)]);
  bf16*Ow=O+(rowbase+q0+wid*QBLK)*DM+h*D;
  { bf16*stg=(bf16*)(shm+LDS_OST)+wid*2048;
    #pragma unroll
    for(int r=0;r<16;++r){const int orow=crow(r,hi);
      #pragma unroll
      for(int d0=0;d0<2;++d0)stg[orow*64+d0*32+r32]=__float2bfloat16(o[d0][r]*rli[r]);}
    asm volatile("s_waitcnt lgkmcnt(0)":::"memory");
    #pragma unroll
    for(int i=0;i<4;++i){const int row=i*8+(lane>>3),ch=lane&7; const u32x4 v=*(const u32x4*)(stg+row*64+ch*8); ATTN_STORE16(Ow+(long)row*DM+ch*8,v);} }
  asm volatile("s_waitcnt lgkmcnt(0)\n\ts_barrier":::"memory");
  #undef DMA_K
  #undef DMA_V
  #undef CMASK
  #undef START
  #undef RESC
  #undef ROT
}
constexpr int ATTN_LDS_BYTES=LDS_BYTES;
#undef CINIT
#undef LDF4
#undef SBAR
#undef WAIT_BAR
}
#define GAS __attribute__((address_space(1)))
#define LAS __attribute__((address_space(3)))
typedef unsigned short bf16;
typedef unsigned v4u __attribute__((ext_vector_type(4)));
typedef float f32x4 __attribute__((ext_vector_type(4)));
typedef short bf16x8 __attribute__((ext_vector_type(8)));
typedef GAS unsigned gu32;
typedef GAS unsigned long long gu64;
#define RLX_AGENT __ATOMIC_RELAXED, __HIP_MEMORY_SCOPE_AGENT
#define LDS_WAIT() asm volatile("s_waitcnt lgkmcnt(0)" ::: "memory")
#define VM_WAIT() asm volatile("s_waitcnt vmcnt(0)" ::: "memory")
__device__ __forceinline__ unsigned long long rt() { return __builtin_amdgcn_s_memrealtime(); }
__device__ __forceinline__ unsigned f2bf(float f) { unsigned u = __builtin_bit_cast(unsigned, f); return (u + 0x7fffu + ((u >> 16) & 1u)) >> 16; }
__device__ __forceinline__ unsigned pk2(float lo, float hi) { return f2bf(lo) | (f2bf(hi) << 16); }

#define XB_TMO      128
#define XB_XCNT(j)  (256  + 64 * (j))
#define XB_XSUB(j)  (1280 + 64 * (j))
#define XB_XGEN(j)  (2304 + 64 * (j))
#define XB_TOP      3328
#define XB_TOPGEN   3392
#define XCD_BAR_WORDS 3456
#define XB_SPIN_CAP (1u << 18)

__device__ __forceinline__ unsigned xb_ld(unsigned* p)              { return __hip_atomic_load(p, __ATOMIC_RELAXED, __HIP_MEMORY_SCOPE_AGENT); }
__device__ __forceinline__ unsigned xb_add(unsigned* p, unsigned v) { return __hip_atomic_fetch_add(p, v, __ATOMIC_RELAXED, __HIP_MEMORY_SCOPE_AGENT); }
__device__ __forceinline__ unsigned xb_xcc_id() { return (unsigned)__builtin_amdgcn_s_getreg((3 << 11) | 20) & 0xFu; }
#define XB_SPIN(cond, bar) do { unsigned _sp = 0; while (cond) { __builtin_amdgcn_s_sleep(1); \
    if ((++_sp & 255u) == 0u) { if (xb_ld(&(bar)[XB_TMO])) break; if (_sp > XB_SPIN_CAP) { atomicAdd(&(bar)[XB_TMO], 1u); break; } } } } while (0)

struct XcdBarrier {
    unsigned* bar; unsigned x;
    volatile LAS unsigned* st;
};

__device__ __forceinline__ XcdBarrier xcd_barrier_post(unsigned* bar, volatile LAS unsigned* st) {
    XcdBarrier b; b.bar = bar; b.x = xb_xcc_id(); b.st = st;
    if (threadIdx.x == 0) (void)xb_add(&bar[XB_XCNT(b.x)], 1u);
    return b;
}
__device__ __forceinline__ void xcd_barrier_complete(unsigned* bar, unsigned x, unsigned& nloc, unsigned& nx) {
    const unsigned G = gridDim.x * gridDim.y * gridDim.z;
    unsigned sum, cnt, mine, sp = 0u;
    for (;;) {
        sum = 0u; cnt = 0u; mine = 0u;
#pragma unroll
        for (unsigned j = 0; j < 16; ++j) { const unsigned c = xb_ld(&bar[XB_XCNT(j)]); sum += c; cnt += (c > 0u) ? 1u : 0u; mine = (j == x) ? c : mine; }
        if (sum == G) break;
        __builtin_amdgcn_s_sleep(1);
        if ((++sp & 255u) == 0u) { if (xb_ld(&bar[XB_TMO])) break; if (sp > XB_SPIN_CAP) { atomicAdd(&bar[XB_TMO], 1u); break; } }
    }
    nloc = mine > 0u ? mine : 1u; nx = cnt > 0u ? cnt : 1u;
}

__device__ __forceinline__ void xcd_barrier(const XcdBarrier& b) {
    asm volatile("s_waitcnt vmcnt(0)" ::: "memory");
    __syncthreads();
    if (threadIdx.x == 0) {
        unsigned* bar = b.bar;
        __builtin_amdgcn_s_waitcnt(0);
        unsigned nloc = b.st[0], nx = b.st[1];
        if (nloc == 0u) { xcd_barrier_complete(bar, b.x, nloc, nx); b.st[0] = nloc; b.st[1] = nx; }
        const unsigned old = xb_add(&bar[XB_XSUB(b.x)], 1u);
        const unsigned gen = old / nloc;
        if (old + 1u == (gen + 1u) * nloc) {
            __builtin_amdgcn_fence(__ATOMIC_RELEASE, "agent");
            asm volatile("s_waitcnt vmcnt(0)" ::: "memory");
            const unsigned og = xb_add(&bar[XB_TOP], 1u);
            const unsigned tg = og / nx;
            if (og + 1u == (tg + 1u) * nx) xb_add(&bar[XB_TOPGEN], 1u);
            else XB_SPIN(xb_ld(&bar[XB_TOPGEN]) == tg, bar);
            __builtin_amdgcn_fence(__ATOMIC_ACQUIRE, "agent");
            xb_add(&bar[XB_XGEN(b.x)], 1u);
            asm volatile("s_waitcnt vmcnt(0)" ::: "memory");
        } else {
            XB_SPIN(xb_ld(&bar[XB_XGEN(b.x)]) == gen, bar);
            __builtin_amdgcn_fence(__ATOMIC_ACQUIRE, "agent");
            asm volatile("s_waitcnt vmcnt(0)" ::: "memory");
        }
    }
    __syncthreads();
}

struct Args { const float* in[17]; float* out; unsigned char* ws; };
typedef const __attribute__((address_space(4))) Args* KArgs;
struct Frame {
    LAS unsigned char* lds;
    volatile LAS unsigned* MISC;
    int tid, lane, wave;
    int vcu, G;
    KArgs ka;
    __device__ __forceinline__ void phase() { KArgs p = (KArgs)__builtin_amdgcn_kernarg_segment_ptr(); asm volatile("" : "+s"(p)); ka = p; int t = threadIdx.x; asm volatile("" : "+v"(t)); tid = t; lane = t & 63; wave = __builtin_amdgcn_readfirstlane(t >> 6); }
    __device__ __forceinline__ const float* in(int i) const { return ka->in[i]; }
    __device__ __forceinline__ float* out() const { return ka->out; }
    __device__ __forceinline__ unsigned char* ws() const { return ka->ws; }
    __device__ __forceinline__ const float* x() const { return in(0); }
    __device__ __forceinline__ const float* c() const { return in(1); }
    __device__ __forceinline__ const float* w_ada() const { return in(2); }
    __device__ __forceinline__ const float* b_ada() const { return in(3); }
    __device__ __forceinline__ const float* w1i() const { return in(4); }
    __device__ __forceinline__ const float* w1o() const { return in(5); }
    __device__ __forceinline__ const float* wmi() const { return in(6); }
    __device__ __forceinline__ const float* b_fox_f() const { return in(7); }
    __device__ __forceinline__ const float* b_m_i() const { return in(8); }
    __device__ __forceinline__ const float* b_m_f() const { return in(9); }
    __device__ __forceinline__ const float* w_conv() const { return in(10); }
    __device__ __forceinline__ const float* b_conv() const { return in(11); }
    __device__ __forceinline__ const float* g_mhn() const { return in(12); }
    __device__ __forceinline__ const float* wmo() const { return in(13); }
    __device__ __forceinline__ const float* w2i() const { return in(14); }
    __device__ __forceinline__ const float* w2o() const { return in(15); }
    __device__ __forceinline__ const float* g_final() const { return in(16); }
    __device__ __forceinline__ gu32* ctl() const { return (gu32*)(ws() + WS_CTL); }
    __device__ __forceinline__ bf16* W1I_t() const { return (bf16*)(ws() + WS_W1I); }
    __device__ __forceinline__ bf16* W1O_t() const { return (bf16*)(ws() + WS_W1O); }
    __device__ __forceinline__ bf16* WMI_t() const { return (bf16*)(ws() + WS_WMI); }
    __device__ __forceinline__ bf16* WMO_t() const { return (bf16*)(ws() + WS_WMO); }
    __device__ __forceinline__ bf16* W2I_t() const { return (bf16*)(ws() + WS_W2I); }
    __device__ __forceinline__ bf16* W2O_t() const { return (bf16*)(ws() + WS_W2O); }
    __device__ __forceinline__ bf16* XN() const { return (bf16*)(ws() + WS_XN); }
    __device__ __forceinline__ bf16* Y() const { return (bf16*)(ws() + WS_Y); }
    __device__ __forceinline__ bf16* ACT() const { return (bf16*)(ws() + WS_ACT); }
    __device__ __forceinline__ bf16* MIXB() const { return (bf16*)(ws() + WS_ACT); }
    __device__ __forceinline__ float* MOD() const { return (float*)(ws() + WS_MOD); }
    __device__ __forceinline__ float* GATES() const { return (float*)(ws() + WS_GATES); }
    __device__ __forceinline__ float* HB() const { return (float*)(ws() + WS_XN); }
    __device__ __forceinline__ bf16* QC() const { return (bf16*)(ws() + WS_QC); }
    __device__ __forceinline__ bf16* KC() const { return (bf16*)(ws() + WS_KC); }
    __device__ __forceinline__ float* MS() const { return (float*)(ws() + WS_MS); }
    __device__ __forceinline__ float* DEC() const { return (float*)(ws() + WS_DEC); }
    __device__ __forceinline__ float* CB() const { return (float*)(ws() + WS_CB); }
};

__device__ __forceinline__ float wave_sum(float v) {
#pragma unroll
    for (int o = 1; o < 64; o <<= 1) v += __shfl_xor(v, o);
    return v;
}
__device__ __forceinline__ float silu_d(float g) { return g / (1.0f + __expf(-g)); }
__device__ __forceinline__ float logsigmoid_d(float x) { return fminf(x, 0.0f) - log1pf(__expf(-fabsf(x))); }
__device__ __forceinline__ float bf2f(bf16 v) { return __uint_as_float((unsigned)v << 16); }

__device__ __forceinline__ void transpose_item(const float* W, int N, int Kd, int k0, int nsrc0, bf16* WT, int drow0, LAS float* scr, int lane) {
#pragma unroll 8
    for (int i = 0; i < 32; ++i) { const int kk = 2 * i + (lane >> 5); scr[kk * 33 + (lane & 31)] = W[(size_t)(k0 + kk) * N + nsrc0 + (lane & 31)]; }
    LDS_WAIT(); asm volatile("" ::: "memory");
    const int c = lane & 7;
#pragma unroll
    for (int j = 0; j < 4; ++j) { const int n = (lane >> 3) + 8 * j; const LAS float* s = scr + (8 * c) * 33 + n;
        v4u o; o.x = pk2(s[0 * 33], s[1 * 33]); o.y = pk2(s[2 * 33], s[3 * 33]); o.z = pk2(s[4 * 33], s[5 * 33]); o.w = pk2(s[6 * 33], s[7 * 33]);
        *(GAS v4u*)(WT + (size_t)(drow0 + n) * Kd + k0 + 8 * c) = o; }
    LDS_WAIT(); asm volatile("" ::: "memory");
}
__device__ __forceinline__ void gate_tile_item(const float* W, bf16* WT, int kb, int lane) {
    const int k = kb * 64 + lane;
    for (int r = 0; r < 256; ++r) {
        float v = 0.f;
        if (r < 16) { const int sc = (r < 8) ? (1536 + r) : (3592 + (r - 8)); v = W[(size_t)k * MIXN + sc]; }
        WT[(size_t)(3584 + r) * D + k] = (bf16)f2bf(v);
    }
}
__device__ __forceinline__ void ada_item(const Frame& F, int a, const LAS float* cact) {
    const int cl = F.lane & 7, kp = F.lane >> 3, col = 32 * a + 4 * cl;
    f32x4 acc[4];
#pragma unroll
    for (int b = 0; b < 4; ++b) acc[b] = (f32x4){0.f, 0.f, 0.f, 0.f};
    const float* wp = F.w_ada() + (size_t)kp * NMOD + col;
#pragma unroll 1
    for (int k0 = 0; k0 < D; k0 += 128) {
        f32x4 w[16];
#pragma unroll
        for (int i = 0; i < 16; ++i) w[i] = *(const GAS f32x4*)(wp + (size_t)(k0 + 8 * i) * NMOD);
#pragma unroll
        for (int i = 0; i < 16; ++i) { const int k = k0 + 8 * i + kp;
#pragma unroll
            for (int b = 0; b < 4; ++b) acc[b] += w[i] * cact[b * D + k]; }
    }
#pragma unroll
    for (int b = 0; b < 4; ++b)
#pragma unroll
        for (int j = 0; j < 4; ++j) { float v = acc[b][j]; v += __shfl_xor(v, 8); v += __shfl_xor(v, 16); v += __shfl_xor(v, 32); acc[b][j] = v; }
    if (kp == 0) { const f32x4 bb = *(const GAS f32x4*)(F.b_ada() + col);
#pragma unroll
        for (int b = 0; b < 4; ++b) *(GAS f32x4*)(F.MOD() + (size_t)b * NMOD + col) = acc[b] + bb; }
}

__device__ __forceinline__ void p0_prologue(Frame& F) {
    LAS float* scr = (LAS float*)(F.lds + F.wave * 8704);
    LAS float* cact = (LAS float*)(F.lds + 8 * 8704);
    for (int i = F.tid; i < BATCH * D; i += NWAVES * 64) cact[i] = silu_d(F.c()[i]);
    __syncthreads();
    if (F.wave == 0) { for (int a = F.vcu; a < NMOD / 32; a += 8 * F.G) ada_item(F, a, cact); }
    if (F.wave == 1) { for (int a = F.G + F.vcu; a < NMOD / 32; a += 8 * F.G) ada_item(F, a, cact); }
    const int gw = F.vcu * NWAVES + F.wave, NGW = F.G * NWAVES;
    constexpr int I_FI = (D / 64) * (2 * FF / 32), I_FO = (FF / 64) * (D / 32), I_MI = (D / 64) * (3584 / 32), I_MO = (D / 64) * (D / 32), I_G = D / 64;
    constexpr int NITEMS = 2 * I_FI + 2 * I_FO + I_MI + I_MO + I_G;
    for (int it = gw; it < NITEMS; it += NGW) {
        int r = it;
        if (r < 2 * I_FI) {
            const float* W = (r < I_FI) ? F.w1i() : F.w2i(); bf16* WT = (r < I_FI) ? F.W1I_t() : F.W2I_t(); if (r >= I_FI) r -= I_FI;
            const int nrb = 2 * FF / 32, kb = r / nrb, rb = r % nrb, drow = rb * 32, tile = drow >> 8, within = drow & 255, half = within >> 7, hid = tile * 128 + (within & 127);
            transpose_item(W, 2 * FF, D, kb * 64, half * FF + hid, WT, drow, scr, F.lane); continue; }
        r -= 2 * I_FI;
        if (r < 2 * I_FO) {
            const float* W = (r < I_FO) ? F.w1o() : F.w2o(); bf16* WT = (r < I_FO) ? F.W1O_t() : F.W2O_t(); if (r >= I_FO) r -= I_FO;
            const int nrb = D / 32, kb = r / nrb, rb = r % nrb;
            transpose_item(W, D, FF, kb * 64, rb * 32, WT, rb * 32, scr, F.lane); continue; }
        r -= 2 * I_FO;
        if (r < I_MI) {
            const int nrb = 3584 / 32, kb = r / nrb, rb = r % nrb, drow = rb * 32, t = drow >> 9, src = (t < 3 ? 512 * t : 512 * t + 8) + (drow & 511);
            transpose_item(F.wmi(), MIXN, D, kb * 64, src, F.WMI_t(), drow, scr, F.lane); continue; }
        r -= I_MI;
        if (r < I_MO) { const int nrb = D / 32, kb = r / nrb, rb = r % nrb; transpose_item(F.wmo(), D, D, kb * 64, rb * 32, F.WMO_t(), rb * 32, scr, F.lane); continue; }
        r -= I_MO;
        gate_tile_item(F.wmi(), F.WMI_t(), r, F.lane);
    }
}

__device__ __forceinline__ void norm_mod_rows(Frame& F, const float* src, bf16* dst, int shift_off, int scale_off) {
    const int gw = F.vcu * NWAVES + F.wave, NGW = F.G * NWAVES;
    for (int m = gw; m < M; m += NGW) {
        const GAS f32x4* xr = (const GAS f32x4*)(src + (size_t)m * D) + F.lane;
        const float* mb = F.MOD() + (size_t)(m / SEQ) * NMOD;
        f32x4 v[4]; float s = 0.f;
#pragma unroll
        for (int j = 0; j < 4; ++j) { v[j] = xr[64 * j]; s += (v[j].x * v[j].x + v[j].y * v[j].y) + (v[j].z * v[j].z + v[j].w * v[j].w); }
        const float rstd = 1.f / sqrtf(wave_sum(s) * (1.f / D) + EPS);
        GAS unsigned long long* o8 = (GAS unsigned long long*)(dst + (size_t)m * D) + F.lane;
#pragma unroll
        for (int j = 0; j < 4; ++j) { const f32x4 sh = *((const GAS f32x4*)(mb + shift_off) + F.lane + 64 * j), sc = *((const GAS f32x4*)(mb + scale_off) + F.lane + 64 * j);
            const f32x4 h = v[j] * rstd * (sc + 1.0f) + sh;
            o8[64 * j] = (unsigned long long)pk2(h.x, h.y) | ((unsigned long long)pk2(h.z, h.w) << 32); }
    }
}
__device__ __forceinline__ void final_norm_rows(Frame& F, float* xio) {
    const int gw = F.vcu * NWAVES + F.wave, NGW = F.G * NWAVES;
    for (int m = gw; m < M; m += NGW) {
        GAS f32x4* xr = (GAS f32x4*)(xio + (size_t)m * D) + F.lane;
        f32x4 v[4]; float s = 0.f;
#pragma unroll
        for (int j = 0; j < 4; ++j) { v[j] = xr[64 * j]; s += (v[j].x * v[j].x + v[j].y * v[j].y) + (v[j].z * v[j].z + v[j].w * v[j].w); }
        const float rstd = 1.f / sqrtf(wave_sum(s) * (1.f / D) + EPS);
#pragma unroll
        for (int j = 0; j < 4; ++j) { const f32x4 g = *((const GAS f32x4*)F.g_final() + F.lane + 64 * j); xr[64 * j] = v[j] * rstd * g; }
    }
}
__device__ __forceinline__ void mlstm_fixup_rows(Frame& F) {
    const int gw = F.vcu * NWAVES + F.wave, NGW = F.G * NWAVES;
    const bf16* MO = F.MIXB() + (size_t)5 * M * 512;
    for (int m = gw; m < M; m += NGW) {
        const GAS f32x4* hp = (const GAS f32x4*)(F.HB() + (size_t)m * 512 + 8 * F.lane);
        const f32x4 h0 = hp[0], h1 = hp[1];
        float s = (h0.x * h0.x + h0.y * h0.y) + (h0.z * h0.z + h0.w * h0.w) + (h1.x * h1.x + h1.y * h1.y) + (h1.z * h1.z + h1.w * h1.w);
        s += __shfl_xor(s, 1); s += __shfl_xor(s, 2); s += __shfl_xor(s, 4); s += __shfl_xor(s, 8);
        const float rstd = 1.f / sqrtf(s * (1.f / 128.f) + EPS);
        const v4u mo = *(const GAS v4u*)(MO + (size_t)m * 512 + 8 * F.lane);
        const GAS f32x4* gp = (const GAS f32x4*)(F.g_mhn() + 8 * F.lane); const f32x4 g0 = gp[0], g1 = gp[1];
        float o[8]; const float hh[8] = {h0.x, h0.y, h0.z, h0.w, h1.x, h1.y, h1.z, h1.w}; const float gg[8] = {g0.x, g0.y, g0.z, g0.w, g1.x, g1.y, g1.z, g1.w};
        const unsigned mw[4] = {mo.x, mo.y, mo.z, mo.w};
#pragma unroll
        for (int j = 0; j < 8; ++j) { const float mov = __uint_as_float((j & 1) ? (mw[j >> 1] & 0xffff0000u) : (mw[j >> 1] << 16)); o[j] = (1.0f / (1.0f + __expf(-mov))) * (hh[j] * rstd * gg[j]); }
        v4u w; w.x = pk2(o[0], o[1]); w.y = pk2(o[2], o[3]); w.z = pk2(o[4], o[5]); w.w = pk2(o[6], o[7]);
        *(GAS v4u*)(F.Y() + (size_t)m * D + 512 + 8 * F.lane) = w;
    }
}

__device__ __forceinline__ void fox_cumsum(Frame& F, int b, int h, int n, LAS float* cb, LAS float* scratch) {
    const float bias = F.b_fox_f()[h];
    const int i0 = F.tid * 8;
    float v[8]; float run = 0.f;
#pragma unroll
    for (int j = 0; j < 8; ++j) { float lf = 0.f; if (i0 + j < n) lf = logsigmoid_d(F.GATES()[(size_t)(b * SEQ + i0 + j) * 16 + h] + bias); run += lf; v[j] = run; }
    float tot = run;
#pragma unroll
    for (int o = 1; o < 64; o <<= 1) { const float t = __shfl_up(tot, o); if (F.lane >= o) tot += t; }
    if (F.lane == 63) scratch[F.wave] = tot;
    __syncthreads();
    float woff = 0.f;
#pragma unroll
    for (int w = 0; w < 8; ++w) { const float s = scratch[w]; if (w < F.wave) woff += s; }
    const float base = woff + tot - run;
#pragma unroll
    for (int j = 0; j < 8; ++j) if (i0 + j < n) cb[i0 + j] = (base + v[j]) * 1.4426950408889634f;
    __syncthreads();
}

__device__ __forceinline__ void attn_naive_unit(Frame& F, int b, int h, int qb) {
    LAS float* cb = (LAS float*)F.lds;
    LAS float* Ks = cb + 4096;
    LAS float* Vs = Ks + 4096;
    LAS float* scr = Vs + 4096;
    const bf16* FK = F.MIXB(); const bf16* FV = F.MIXB() + (size_t)M * 512;
    fox_cumsum(F, b, h, (qb + 1) * 256, cb, scr);
    const int r = F.tid & 255, dh = F.tid >> 8, t = qb * 256 + r; const size_t grow = (size_t)b * SEQ + t;
    unsigned qp[32]; float o[32];
    { const v4u* qptr = (const v4u*)(F.Y() + grow * D + h * 64);
#pragma unroll
      for (int c = 0; c < 8; ++c) { const v4u w = qptr[c]; qp[4 * c] = w.x; qp[4 * c + 1] = w.y; qp[4 * c + 2] = w.z; qp[4 * c + 3] = w.w; } }
#pragma unroll
    for (int d = 0; d < 32; ++d) o[d] = 0.f;
    float mrun = -1e30f, l = 0.f;
    const int NT = 4 * (qb + 1);
#pragma unroll 1
    for (int kt = 0; kt < NT; ++kt) {
        __syncthreads();
        { const int s = F.tid >> 3, d0 = (F.tid & 7) * 8; const size_t krow = (size_t)b * SEQ + kt * 64 + s;
          const v4u kw = *(const v4u*)(FK + krow * 512 + h * 64 + d0), vw = *(const v4u*)(FV + krow * 512 + h * 64 + d0);
          const unsigned kk[4] = {kw.x, kw.y, kw.z, kw.w}, vv[4] = {vw.x, vw.y, vw.z, vw.w};
#pragma unroll
          for (int j = 0; j < 4; ++j) { Ks[s * 64 + d0 + 2 * j] = __uint_as_float(kk[j] << 16); Ks[s * 64 + d0 + 2 * j + 1] = __uint_as_float(kk[j] & 0xffff0000u);
                                        Vs[s * 64 + d0 + 2 * j] = __uint_as_float(vv[j] << 16); Vs[s * 64 + d0 + 2 * j + 1] = __uint_as_float(vv[j] & 0xffff0000u); } }
        __syncthreads();
#pragma unroll 1
        for (int s = 0; s < 64; ++s) {
            const int kp = kt * 64 + s;
            if (kp <= t) {
                float dot = 0.f;
#pragma unroll
                for (int d = 0; d < 64; d += 4) { const f32x4 kv = *(const LAS f32x4*)(Ks + s * 64 + d);
                    dot += __uint_as_float(qp[d >> 1] << 16) * kv.x + __uint_as_float(qp[d >> 1] & 0xffff0000u) * kv.y + __uint_as_float(qp[(d >> 1) + 1] << 16) * kv.z + __uint_as_float(qp[(d >> 1) + 1] & 0xffff0000u) * kv.w; }
                const float sc = dot - cb[kp];
                if (sc > mrun) { const float f = exp2f(mrun - sc); l *= f;
#pragma unroll
                    for (int d = 0; d < 32; ++d) o[d] *= f;
                    mrun = sc; }
                const float p = exp2f(sc - mrun); l += p;
#pragma unroll
                for (int d = 0; d < 32; d += 4) { const f32x4 vv = *(const LAS f32x4*)(Vs + s * 64 + dh * 32 + d); o[d] += p * vv.x; o[d + 1] += p * vv.y; o[d + 2] += p * vv.z; o[d + 3] += p * vv.w; }
            }
        }
    }
    __syncthreads();
    { const float inv = 1.0f / l;
      v4u* op = (v4u*)(F.Y() + grow * D + h * 64 + dh * 32);
#pragma unroll
      for (int c = 0; c < 4; ++c) op[c] = (v4u){pk2(o[8 * c] * inv, o[8 * c + 1] * inv), pk2(o[8 * c + 2] * inv, o[8 * c + 3] * inv), pk2(o[8 * c + 4] * inv, o[8 * c + 5] * inv), pk2(o[8 * c + 6] * inv, o[8 * c + 7] * inv)}; }
    __syncthreads();
}

__device__ __forceinline__ void attn_fast_unit(Frame& F, int b, int h, int qb) {
    LAS float* cb = (LAS float*)(F.lds + 86016);
    { const float* cbg = F.CB() + (size_t)(b * 8 + h) * SEQ; const int i0 = F.tid * 8;
      if (i0 < (qb + 1) * 256) { *(LAS f32x4*)(cb + i0) = *(const GAS f32x4*)(cbg + i0); *(LAS f32x4*)(cb + i0 + 4) = *(const GAS f32x4*)(cbg + i0 + 4); }
      __syncthreads(); }
    const attn_body::bf16* FK = (const attn_body::bf16*)F.MIXB(); const attn_body::bf16* FV = FK + (size_t)M * 512;
    attn_body::attn_unit<8>(b, h, qb, (const attn_body::bf16*)F.Y(), FK, FV, (attn_body::bf16*)F.Y(), (char*)F.lds, (attn_body::lds_fptr)cb);
}

__device__ __forceinline__ void mlstm_naive_unit(Frame& F, int b, int h, int db) {
    LAS float* L = (LAS float*)F.lds;
    LAS float* qs = L;
    LAS float* ks = qs + 64 * 129;
    LAS float* vs = ks + 64 * 129;
    LAS float* Cs = vs + 64 * 33;
    LAS float* ns = Cs + 32 * 129;
    LAS float* Sm = ns + 128;
    LAS float* av = Sm + 64 * 65;
    LAS float* icv = av + 64;
    LAS float* mtv = icv + 64;
    LAS float* iwv = mtv + 64;
    LAS float* wtv = iwv + 64;
    LAS float* denv = wtv + 64;
    LAS float* scl = denv + 64;
    const bf16* MQ = F.MIXB() + (size_t)2 * M * 512; const bf16* MK = F.MIXB() + (size_t)3 * M * 512; const bf16* MV = F.MIXB() + (size_t)4 * M * 512;
    for (int i = F.tid; i < 32 * 129; i += 512) Cs[i] = 0.f;
    if (F.tid < 128) ns[F.tid] = 0.f;
    float mstate = 0.f;
    const float bi = F.b_m_i()[h], bfg = F.b_m_f()[h];
    __syncthreads();
#pragma unroll 1
    for (int j = 0; j < SEQ / 64; ++j) {
        const int t0 = 64 * j; const size_t grow0 = (size_t)b * SEQ + t0;
#pragma unroll 1
        for (int n = 0; n < 16; ++n) { const int idx = F.tid + 512 * n, t = idx >> 7, c = idx & 127, ch = h * 128 + c;
            float aq = F.b_conv()[ch], ak = F.b_conv()[512 + ch];
#pragma unroll
            for (int w = 0; w < 4; ++w) { const int tt = t0 + t - 3 + w; if (tt >= 0) { const size_t ro = ((size_t)b * SEQ + tt) * 512 + ch; aq += F.w_conv()[w * 1024 + ch] * bf2f(MQ[ro]); ak += F.w_conv()[w * 1024 + 512 + ch] * bf2f(MK[ro]); } }
            qs[t * 129 + c] = silu_d(aq); ks[t * 129 + c] = silu_d(ak) * 0.08838834764831845f; }
#pragma unroll 1
        for (int n = 0; n < 4; ++n) { const int idx = F.tid + 512 * n, t = idx >> 5, d = idx & 31; vs[t * 33 + d] = bf2f(MV[(grow0 + t) * 512 + h * 128 + db * 32 + d]); }
        if (F.wave == 0) { const int l = F.lane;
            const float ic = F.GATES()[(grow0 + l) * 16 + 8 + h] + bi; const float lf = logsigmoid_d(F.GATES()[(grow0 + l) * 16 + 12 + h] + bfg);
            float a = lf;
#pragma unroll
            for (int o = 1; o < 64; o <<= 1) { const float t = __shfl_up(a, o); if (l >= o) a += t; }
            const float g = __shfl(a, 63);
            float pm = ic - a;
#pragma unroll
            for (int o = 1; o < 64; o <<= 1) { const float t = __shfl_up(pm, o); if (l >= o) pm = fmaxf(pm, t); }
            const float mt = fmaxf(a + mstate, a + pm);
            const float wend = g - a + ic; float mw = wend;
#pragma unroll
            for (int o = 1; o < 64; o <<= 1) mw = fmaxf(mw, __shfl_xor(mw, o));
            const float mnew = fmaxf(g + mstate, mw);
            av[l] = a; icv[l] = ic; mtv[l] = mt; iwv[l] = __expf(a + mstate - mt); wtv[l] = __expf(wend - mnew);
            if (l == 0) scl[0] = __expf(g + mstate - mnew);
            mstate = mnew; }
        __syncthreads();
        { const int t = F.tid >> 3;
#pragma unroll 1
          for (int jj = 0; jj < 8; ++jj) { const int s = (F.tid & 7) + 8 * jj; float dot = 0.f;
#pragma unroll 4
              for (int e = 0; e < 128; ++e) dot += qs[t * 129 + e] * ks[s * 129 + e];
              Sm[t * 65 + s] = (s <= t) ? dot * __expf(av[t] - av[s] + icv[s] - mtv[t]) : 0.f; } }
        __syncthreads();
        if (F.tid < 64) { const int t = F.tid; float ds = 0.f, dn = 0.f;
            for (int s = 0; s < 64; ++s) ds += Sm[t * 65 + s];
            for (int e = 0; e < 128; ++e) dn += ns[e] * qs[t * 129 + e];
            denv[t] = ds + iwv[t] * dn; }
        __syncthreads();
#pragma unroll 1
        for (int n = 0; n < 4; ++n) { const int idx = F.tid + 512 * n, t = idx >> 5, d = idx & 31; float intra = 0.f, inter = 0.f;
#pragma unroll 4
            for (int s = 0; s < 64; ++s) intra += Sm[t * 65 + s] * vs[s * 33 + d];
#pragma unroll 4
            for (int e = 0; e < 128; ++e) inter += Cs[d * 129 + e] * qs[t * 129 + e];
            const float num = intra + iwv[t] * inter; const float den = fmaxf(fabsf(denv[t]), __expf(-mtv[t]));
            F.HB()[(grow0 + t) * 512 + h * 128 + db * 32 + d] = num / den; }
        __syncthreads();
        { const float decay = scl[0];
#pragma unroll 1
          for (int n = 0; n < 8; ++n) { const int idx = F.tid + 512 * n, d = idx >> 7, e = idx & 127; float acc = 0.f;
#pragma unroll 4
              for (int l = 0; l < 64; ++l) acc += wtv[l] * vs[l * 33 + d] * ks[l * 129 + e];
              Cs[d * 129 + e] = decay * Cs[d * 129 + e] + acc; }
          if (F.tid < 128) { const int e = F.tid; float acc = 0.f; for (int l = 0; l < 64; ++l) acc += wtv[l] * ks[l * 129 + e]; ns[e] = decay * ns[e] + acc; } }
        __syncthreads();
    }
}

__device__ __forceinline__ void mlstm_scalar_series(Frame& F, int series) {
    const int b = series >> 2, h = series & 3, l = F.lane;
    const float bi = F.b_m_i()[h], bfg = F.b_m_f()[h];
    const float* G = F.GATES(); float* MS = F.MS() + (size_t)series * 5 * SEQ; float* DEC = F.DEC() + series * 64;
    float m = 0.f;
#pragma unroll 1
    for (int j = 0; j < SEQ / 64; ++j) {
        const int t = 64 * j + l; const size_t grow = (size_t)b * SEQ + t;
        const float ic = G[grow * 16 + 8 + h] + bi; const float lf = logsigmoid_d(G[grow * 16 + 12 + h] + bfg);
        float a = lf;
#pragma unroll
        for (int o = 1; o < 64; o <<= 1) { const float v = __shfl_up(a, o); if (l >= o) a += v; }
        const float g = __shfl(a, 63);
        float pm = ic - a;
#pragma unroll
        for (int o = 1; o < 64; o <<= 1) { const float v = __shfl_up(pm, o); if (l >= o) pm = fmaxf(pm, v); }
        const float mt = fmaxf(a + m, a + pm);
        const float wend = g - a + ic; float mw = wend;
#pragma unroll
        for (int o = 1; o < 64; o <<= 1) mw = fmaxf(mw, __shfl_xor(mw, o));
        const float mnew = fmaxf(g + m, mw);
        MS[0 * SEQ + t] = (a - mt) * 1.4426950408889634f; MS[1 * SEQ + t] = (ic - a) * 1.4426950408889634f; MS[2 * SEQ + t] = __expf(a + m - mt); MS[3 * SEQ + t] = __expf(-mt); MS[4 * SEQ + t] = __expf(wend - mnew);
        if (l == 0) DEC[j] = __expf(g + m - mnew);
        m = mnew;
    }
}
__device__ __forceinline__ void fox_series(Frame& F, int series) {
    const int b = series >> 3, h = series & 7, l = F.lane; const float bias = F.b_fox_f()[h];
    const float* G = F.GATES(); float* CB = F.CB() + (size_t)series * SEQ; float carry = 0.f;
#pragma unroll 1
    for (int j = 0; j < SEQ / 64; ++j) { const int t = 64 * j + l;
        float a = logsigmoid_d(G[((size_t)b * SEQ + t) * 16 + h] + bias);
#pragma unroll
        for (int o = 1; o < 64; o <<= 1) { const float v = __shfl_up(a, o); if (l >= o) a += v; }
        a += carry; CB[t] = a * 1.4426950408889634f; carry = __shfl(a, 63); }
}
__device__ __forceinline__ void conv_item(Frame& F, int item) {
    const int half = item & 1, m0 = (item >> 1) * 4, t0 = m0 % SEQ, ch = 8 * F.lane;
    const bf16* SRC = F.MIXB() + (size_t)(2 + half) * M * 512; bf16* DST = half ? F.KC() : F.QC();
    const float* wc = F.w_conv() + half * 512 + ch; const float* bc = F.b_conv() + half * 512 + ch;
    float w[4][8], bb[8];
#pragma unroll
    for (int k = 0; k < 4; ++k) { const f32x4 w0 = *(const GAS f32x4*)(wc + k * 1024), w1 = *(const GAS f32x4*)(wc + k * 1024 + 4); w[k][0] = w0.x; w[k][1] = w0.y; w[k][2] = w0.z; w[k][3] = w0.w; w[k][4] = w1.x; w[k][5] = w1.y; w[k][6] = w1.z; w[k][7] = w1.w; }
    { const f32x4 b0 = *(const GAS f32x4*)bc, b1 = *(const GAS f32x4*)(bc + 4); bb[0] = b0.x; bb[1] = b0.y; bb[2] = b0.z; bb[3] = b0.w; bb[4] = b1.x; bb[5] = b1.y; bb[6] = b1.z; bb[7] = b1.w; }
    v4u raw[7];
#pragma unroll
    for (int r = 0; r < 7; ++r) { raw[r] = (v4u){0u, 0u, 0u, 0u}; if (t0 + r - 3 >= 0) raw[r] = *(const GAS v4u*)(SRC + (size_t)(m0 + r - 3) * 512 + ch); }
    const float osc = half ? 0.08838834764831845f : 1.0f;
#pragma unroll
    for (int r = 0; r < 4; ++r) {
        float acc[8];
#pragma unroll
        for (int c = 0; c < 8; ++c) acc[c] = bb[c];
#pragma unroll
        for (int k = 0; k < 4; ++k) { const v4u rw = raw[r + k]; const unsigned ww[4] = {rw.x, rw.y, rw.z, rw.w};
#pragma unroll
            for (int c = 0; c < 8; ++c) { const float xv = __uint_as_float((c & 1) ? (ww[c >> 1] & 0xffff0000u) : (ww[c >> 1] << 16)); acc[c] += w[k][c] * xv; } }
#pragma unroll
        for (int c = 0; c < 8; ++c) acc[c] = silu_d(acc[c]) * osc;
        *(GAS v4u*)(DST + (size_t)(m0 + r) * 512 + ch) = (v4u){pk2(acc[0], acc[1]), pk2(acc[2], acc[3]), pk2(acc[4], acc[5]), pk2(acc[6], acc[7])};
    }
}
__device__ __forceinline__ void mixprep_phase(Frame& F) {
    if (F.wave == 0) { if (F.vcu < 16) mlstm_scalar_series(F, F.vcu); else if (F.vcu < 48) fox_series(F, F.vcu - 16); }
    else { const int cw = F.vcu * 7 + F.wave - 1, NCW = F.G * 7;
#pragma unroll 1
        for (int it = cw; it < (M / 4) * 2; it += NCW) conv_item(F, it); }
}

namespace ml {
typedef short s16x4 __attribute__((ext_vector_type(4)));
constexpr int PQ = 272, PV = 144;
constexpr int O_QC = 0, O_KC = 64 * PQ, O_VT = 2 * 64 * PQ, O_VW = O_VT + 32 * PV, O_SC = O_VW + 48 * PV, BUF = 47872;
constexpr int O_CB = 2 * BUF, CBB = 48 * PQ, O_DS = O_CB + 2 * CBB, LDS_END = O_DS + 4 * 64;
static_assert(O_SC + 5 * 256 + 16 <= BUF && LDS_END <= 131072, "mLSTM LDS map");
__device__ __forceinline__ f32x4 mfma16(bf16x8 a, bf16x8 b, f32x4 c) { return __builtin_amdgcn_mfma_f32_16x16x32_bf16(a, b, c, 0, 0, 0); }
__device__ __forceinline__ s16x4 trd(const LAS unsigned char* p) { typedef short v4i16_t __attribute__((ext_vector_type(4))); return __builtin_bit_cast(s16x4, __builtin_amdgcn_ds_read_tr16_b64_v4i16((LAS v4i16_t*)p)); }
__device__ __forceinline__ unsigned pkbf(float lo, float hi) { typedef float f32x2_t __attribute__((ext_vector_type(2))); typedef __bf16 bf16x2_t __attribute__((ext_vector_type(2))); f32x2_t v = {lo, hi}; bf16x2_t r = __builtin_convertvector(v, bf16x2_t); return __builtin_bit_cast(unsigned, r); }
}
__device__ __forceinline__ void mlstm_fast_unit(Frame& F, int b, int h, int db) {
    using namespace ml;
    LAS unsigned char* L = F.lds;
    int tid_ = threadIdx.x; asm volatile("" : "+v"(tid_));
    const int tid = tid_, l = tid & 63, c = l & 15, q = l >> 4, w = __builtin_amdgcn_readfirstlane(tid >> 6);
    const int series = b * 4 + h;
    const bf16* QCg = F.QC() + (size_t)b * SEQ * 512 + h * 128; const bf16* KCg = F.KC() + (size_t)b * SEQ * 512 + h * 128;
    const bf16* Vg = F.MIXB() + (size_t)4 * M * 512 + (size_t)b * SEQ * 512 + h * 128 + db * 32;
    const float* MSg = F.MS() + (size_t)series * 5 * SEQ; const float* DECg = F.DEC() + series * 64;
    float* HBg = F.HB() + (size_t)b * SEQ * 512 + h * 128 + db * 32;
    for (int i = tid; i < 2 * CBB / 4; i += 512) ((LAS unsigned*)(L + O_CB))[i] = 0u;
    for (int i = tid; i < 16 * PV / 4; i += 512) { ((LAS unsigned*)(L + O_VW + 32 * PV))[i] = 0u; ((LAS unsigned*)(L + BUF + O_VW + 32 * PV))[i] = 0u; }
    v4u rq[2], rk[2]; unsigned long long rv; float rsc = 0.f, rwt;
#define ML_LOAD(jn) do { const size_t g0_ = (size_t)(jn) * 64; \
        _Pragma("unroll") for (int k_ = 0; k_ < 2; ++k_) { const int ci_ = tid + 512 * k_, row_ = ci_ >> 4, c16_ = ci_ & 15; \
            rq[k_] = *(const GAS v4u*)(QCg + (g0_ + row_) * 512 + c16_ * 8); rk[k_] = *(const GAS v4u*)(KCg + (g0_ + row_) * 512 + c16_ * 8); } \
        rv = *(const GAS unsigned long long*)(Vg + (g0_ + (tid >> 3)) * 512 + (tid & 7) * 4); \
        rwt = MSg[4 * SEQ + g0_ + (tid >> 3)]; \
        if (tid < 320) rsc = MSg[(size_t)(tid >> 6) * SEQ + g0_ + (tid & 63)]; else if (tid == 320) rsc = DECg[jn]; } while (0)
#define ML_STORE(bufoff) do { LAS unsigned char* B_ = L + (bufoff); \
        _Pragma("unroll") for (int k_ = 0; k_ < 2; ++k_) { const int ci_ = tid + 512 * k_, row_ = ci_ >> 4, c16_ = ci_ & 15; \
            *(LAS v4u*)(B_ + O_QC + row_ * PQ + c16_ * 16) = rq[k_]; *(LAS v4u*)(B_ + O_KC + row_ * PQ + c16_ * 16) = rk[k_]; } \
        { const int s_ = tid >> 3, dc_ = tid & 7; \
          _Pragma("unroll") for (int i_ = 0; i_ < 4; ++i_) { const unsigned short vb_ = (unsigned short)(rv >> (16 * i_)); const float vf_ = __uint_as_float((unsigned)vb_ << 16); \
              *(LAS unsigned short*)(B_ + O_VT + (4 * dc_ + i_) * PV + 2 * s_) = vb_; *(LAS unsigned short*)(B_ + O_VW + (4 * dc_ + i_) * PV + 2 * s_) = (unsigned short)f2bf(vf_ * rwt); } \
          if (dc_ == 0) *(LAS unsigned short*)(B_ + O_VW + 32 * PV + 2 * s_) = (unsigned short)f2bf(rwt); } \
        if (tid <= 320) *(LAS float*)(B_ + O_SC + 4 * tid) = rsc; } while (0)
    ML_LOAD(0);
    __syncthreads();
    ML_STORE(0);
    f32x4 Cacc[3][2];
#pragma unroll
    for (int i = 0; i < 3; ++i)
#pragma unroll
        for (int k = 0; k < 2; ++k) Cacc[i][k] = (f32x4){0.f, 0.f, 0.f, 0.f};
    __syncthreads();
#pragma unroll 1
    for (int j = 0; j < SEQ / 64; ++j) {
        const int cur = (j & 1) * BUF, nxt = BUF - cur;
        const LAS unsigned char* Bc = L + cur; const LAS unsigned char* Cb = L + O_CB + (j & 1) * CBB; LAS unsigned char* Cn = L + O_CB + ((j + 1) & 1) * CBB;
        const LAS float* SC = (const LAS float*)(Bc + O_SC);
        if (j + 1 < SEQ / 64) ML_LOAD(j + 1);
        if (w < 4) {
            bf16x8 qf[4];
#pragma unroll
            for (int ks = 0; ks < 4; ++ks) qf[ks] = *(const LAS bf16x8*)(Bc + O_QC + (16 * w + c) * PQ + (32 * ks + 8 * q) * 2);
            const float A2t = SC[16 * w + c];
            unsigned xs[4][2]; float dsum = 0.f;
#pragma unroll
            for (int si = 0; si < 4; ++si) {
                xs[si][0] = 0u; xs[si][1] = 0u;
                if (si <= w) {
                    f32x4 acc = (f32x4){0.f, 0.f, 0.f, 0.f};
#pragma unroll
                    for (int ks = 0; ks < 4; ++ks) { const bf16x8 af = *(const LAS bf16x8*)(Bc + O_KC + (16 * si + c) * PQ + (32 * ks + 8 * q) * 2); acc = mfma16(af, qf[ks], acc); }
                    const f32x4 b2 = *(const LAS f32x4*)(SC + 64 + 16 * si + 4 * q);
#pragma unroll
                    for (int r = 0; r < 4; ++r) { float p = __builtin_amdgcn_exp2f(A2t + b2[r]); if (si == w && 4 * q + r > c) p = 0.f; acc[r] *= p; }
                    dsum += (acc[0] + acc[1]) + (acc[2] + acc[3]);
                    xs[si][0] = pkbf(acc[0], acc[1]); xs[si][1] = pkbf(acc[2], acc[3]);
                }
            }
            f32x4 z[2] = {(f32x4){0.f, 0.f, 0.f, 0.f}, (f32x4){0.f, 0.f, 0.f, 0.f}};
#pragma unroll
            for (int p = 0; p < 2; ++p) if (2 * p <= w) {
                const bf16x8 af = __builtin_bit_cast(bf16x8, (v4u){xs[2 * p][0], xs[2 * p][1], xs[2 * p + 1][0], xs[2 * p + 1][1]});
#pragma unroll
                for (int dt = 0; dt < 2; ++dt) { const LAS unsigned char* vp = Bc + O_VT + (16 * dt + c) * PV + (32 * p + 4 * q) * 2;
                    const unsigned long long lo = *(const LAS unsigned long long*)vp, hi = *(const LAS unsigned long long*)(vp + 32);
                    const bf16x8 bfr = __builtin_bit_cast(bf16x8, (v4u){(unsigned)lo, (unsigned)(lo >> 32), (unsigned)hi, (unsigned)(hi >> 32)});
                    z[dt] = mfma16(af, bfr, z[dt]); } }
            f32x4 y[3] = {(f32x4){0.f, 0.f, 0.f, 0.f}, (f32x4){0.f, 0.f, 0.f, 0.f}, (f32x4){0.f, 0.f, 0.f, 0.f}};
#pragma unroll
            for (int dt = 0; dt < 3; ++dt)
#pragma unroll
                for (int ks = 0; ks < 4; ++ks) { const bf16x8 bfr = *(const LAS bf16x8*)(Cb + (16 * dt + c) * PQ + (32 * ks + 8 * q) * 2); y[dt] = mfma16(qf[ks], bfr, y[dt]); }
            dsum += __shfl_xor(dsum, 16); dsum += __shfl_xor(dsum, 32);
            LAS float* dscr = (LAS float*)(L + O_DS + w * 64);
            if (q == 0) dscr[c] = dsum;
            const f32x4 iw4 = *(const LAS f32x4*)(SC + 128 + 16 * w + 4 * q), em4 = *(const LAS f32x4*)(SC + 192 + 16 * w + 4 * q);
            f32x4 dint;
#pragma unroll
            for (int r = 0; r < 4; ++r) dint[r] = __shfl(y[2][r], l & 48);
            LDS_WAIT();
            const f32x4 dintra = *(const LAS f32x4*)(dscr + 4 * q);
            float* op = HBg + ((size_t)j * 64 + 16 * w + 4 * q) * 512 + c;
#pragma unroll
            for (int r = 0; r < 4; ++r) { const float den = fmaxf(fabsf(dintra[r] + iw4[r] * dint[r]), em4[r]); const float inv = 1.0f / den;
                op[(size_t)r * 512] = (z[0][r] + iw4[r] * y[0][r]) * inv; op[(size_t)r * 512 + 16] = (z[1][r] + iw4[r] * y[1][r]) * inv; }
        } else {
            const int v = w - 4; const float decay = SC[320];
#pragma unroll
            for (int i = 0; i < 3; ++i)
#pragma unroll
                for (int k = 0; k < 2; ++k) Cacc[i][k] *= decay;
#pragma unroll
            for (int ks = 0; ks < 2; ++ks) {
                bf16x8 af[3];
#pragma unroll
                for (int dt = 0; dt < 3; ++dt) af[dt] = *(const LAS bf16x8*)(Bc + O_VW + (16 * dt + c) * PV + (32 * ks + 8 * q) * 2);
#pragma unroll
                for (int et = 0; et < 2; ++et) { const LAS unsigned char* kp = Bc + O_KC + (32 * ks + 8 * q + (c >> 2)) * PQ + (32 * v + 16 * et + 4 * (c & 3)) * 2;
                    const s16x4 lo = trd(kp), hi = trd(kp + 4 * PQ);
                    const bf16x8 bfr = (bf16x8){lo[0], lo[1], lo[2], lo[3], hi[0], hi[1], hi[2], hi[3]};
#pragma unroll
                    for (int dt = 0; dt < 3; ++dt) Cacc[dt][et] = mfma16(af[dt], bfr, Cacc[dt][et]); }
            }
#pragma unroll
            for (int et = 0; et < 2; ++et) { LAS unsigned char* cp = Cn + (32 * v + 16 * et + c) * 2;
#pragma unroll
                for (int dt = 0; dt < 2; ++dt)
#pragma unroll
                    for (int r = 0; r < 4; ++r) *(LAS unsigned short*)(cp + (16 * dt + 4 * q + r) * PQ) = (unsigned short)f2bf(Cacc[dt][et][r]);
                if (q == 0) *(LAS unsigned short*)(cp + 32 * PQ) = (unsigned short)f2bf(Cacc[2][et][0]); }
        }
        if (j + 1 < SEQ / 64) ML_STORE(nxt);
        __syncthreads();
    }
#undef ML_LOAD
#undef ML_STORE
}

#ifndef NAIVE_ATTN
#define ATTN_UNIT attn_fast_unit
#else
#define ATTN_UNIT attn_naive_unit
#endif
#ifndef NAIVE_MLSTM
#define MLSTM_UNIT mlstm_fast_unit
#else
#define MLSTM_UNIT mlstm_naive_unit
#endif
#ifndef PHM
#define PHM 0x1fff
#endif
__global__ void __launch_bounds__(NWAVES * 64, 2) hymba_fwd(Args args) {
    extern __shared__ __attribute__((aligned(16))) unsigned char lds[];
    Frame F;
    F.lds = (LAS unsigned char*)lds;
    F.MISC = (volatile LAS unsigned*)(F.lds + MISC_OFF);
    F.tid = threadIdx.x; F.lane = F.tid & 63; F.wave = __builtin_amdgcn_readfirstlane(F.tid >> 6);
    F.G = gridDim.x; { const int bx = blockIdx.x; F.vcu = (F.G % 8 == 0) ? (bx % 8) * (F.G / 8) + bx / 8 : bx; }
    F.phase();
    for (int u = F.tid; u < (LDS_BYTES - LDSCTL_OFF) / 4; u += NWAVES * 64) ((LAS unsigned*)(F.lds + LDSCTL_OFF))[u] = 0u;
    __syncthreads();
    XcdBarrier bar = xcd_barrier_post((unsigned*)(F.ctl() + CW_BAR), F.MISC + 8);
#define GRID_BAR() do { xcd_barrier(bar); F.phase(); } while (0)

    if (PHM & 1) p0_prologue(F);
    GRID_BAR();
    if (PHM & 2) norm_mod_rows(F, F.x(), F.XN(), 0 * D, 1 * D);
    GRID_BAR();
    if (PHM & 4) { pg8::Gemm g{F.XN(), F.W1I_t(), M, 2 * FF, D}; pg8::StaticOrder S; S.init(M, 2 * FF, F.G, (int)blockIdx.x);
      pg8::EpiSwiglu E{F.ACT(), FF};
      pg8::gemm_phase<pg8::EpiSwiglu, pg8::StaticOrder, true, true>(F.lds + RING_OFF, g, S, E); }
    GRID_BAR();
    if (PHM & 8) { pg8::Gemm g{F.ACT(), F.W1O_t(), M, D, FF}; pg8::StaticOrder S; S.init(M, D, F.G, (int)blockIdx.x);
      pg8::EpiResGate E{F.x(), F.out(), D, F.MOD() + 2 * D, NMOD, SEQ, 0.5f};
      pg8::gemm_phase<pg8::EpiResGate, pg8::StaticOrder, true, true>(F.lds + RING_OFF, g, S, E); }
    GRID_BAR();
    if (PHM & 16) norm_mod_rows(F, F.out(), F.XN(), 3 * D, 4 * D);
    GRID_BAR();
    if (PHM & 32) { pg8::Gemm g{F.XN(), F.WMI_t(), M, MIXNP, D}; pg8::StaticOrder S; S.init(M, MIXNP, F.G, (int)blockIdx.x);
      pg8::EpiMix E{F.Y(), F.MIXB(), (size_t)M * 512, F.GATES(), QSCALE};
      pg8::gemm_phase<pg8::EpiMix, pg8::StaticOrder, true, true>(F.lds + RING_OFF, g, S, E); }
    GRID_BAR();
    if (PHM & 64) mixprep_phase(F);
    GRID_BAR();
    if (PHM & 64) for (;;) {
        if (F.tid == 0) F.MISC[16] = __hip_atomic_fetch_add(F.ctl() + CW_QUEUE, 1u, RLX_AGENT);
        __syncthreads();
        const int idx = (int)F.MISC[16];
        __syncthreads();
        if (idx >= 64 + 512) break;
#ifndef NO_MLSTM
        if (idx < 64) MLSTM_UNIT(F, idx >> 4, (idx >> 2) & 3, idx & 3);
#else
        if (idx < 64) {}
#endif
        else { const int a = idx - 64; ATTN_UNIT(F, (a & 31) >> 3, a & 7, 15 - (a >> 5)); }
    }
    GRID_BAR();
    if (PHM & 128) mlstm_fixup_rows(F);
    GRID_BAR();
    if (PHM & 256) { pg8::Gemm g{F.Y(), F.WMO_t(), M, D, D}; pg8::StaticOrder S; S.init(M, D, F.G, (int)blockIdx.x);
      pg8::EpiResGate E{F.out(), F.out(), D, F.MOD() + 5 * D, NMOD, SEQ, 1.0f};
      pg8::gemm_phase<pg8::EpiResGate, pg8::StaticOrder, true, true>(F.lds + RING_OFF, g, S, E); }
    GRID_BAR();
    if (PHM & 512) norm_mod_rows(F, F.out(), F.XN(), 6 * D, 7 * D);
    GRID_BAR();
    if (PHM & 1024) { pg8::Gemm g{F.XN(), F.W2I_t(), M, 2 * FF, D}; pg8::StaticOrder S; S.init(M, 2 * FF, F.G, (int)blockIdx.x);
      pg8::EpiSwiglu E{F.ACT(), FF};
      pg8::gemm_phase<pg8::EpiSwiglu, pg8::StaticOrder, true, true>(F.lds + RING_OFF, g, S, E); }
    GRID_BAR();
    if (PHM & 2048) { pg8::Gemm g{F.ACT(), F.W2O_t(), M, D, FF}; pg8::StaticOrder S; S.init(M, D, F.G, (int)blockIdx.x);
      pg8::EpiResGate E{F.out(), F.out(), D, F.MOD() + 8 * D, NMOD, SEQ, 0.5f};
      pg8::gemm_phase<pg8::EpiResGate, pg8::StaticOrder, true, true>(F.lds + RING_OFF, g, S, E); }
    GRID_BAR();
    if (PHM & 4096) final_norm_rows(F, F.out());
}

extern "C" void kernel_launch(void* const* d_in, const int* in_sizes, int n_in, void* d_out, int out_size, void* d_ws, size_t ws_size, hipStream_t stream) {
    static int grid = 0;
    if (grid == 0) {
        if (n_in != 17 || in_sizes[0] != M * D || out_size != M * D || ws_size < WS_END) { fprintf(stderr, "kernel_launch: unexpected shapes (n_in %d, in0 %d, out %d, ws %zu); nothing launched\n", n_in, n_in > 0 ? in_sizes[0] : -1, out_size, ws_size); grid = -1; return; }
        int dev = 0, cus = 0, per_cu = 0;
        if (hipGetDevice(&dev) != hipSuccess || hipDeviceGetAttribute(&cus, hipDeviceAttributeMultiprocessorCount, dev) != hipSuccess) { fprintf(stderr, "kernel_launch: device query failed\n"); grid = -1; return; }
        if (hipFuncSetAttribute((const void*)hymba_fwd, hipFuncAttributeMaxDynamicSharedMemorySize, LDS_BYTES) != hipSuccess) { fprintf(stderr, "kernel_launch: hipFuncSetAttribute failed\n"); grid = -1; return; }
        if (hipOccupancyMaxActiveBlocksPerMultiprocessor(&per_cu, (const void*)hymba_fwd, NWAVES * 64, LDS_BYTES) != hipSuccess || per_cu < 1) { fprintf(stderr, "kernel_launch: occupancy query reports %d workgroups per CU; nothing launched\n", per_cu); (void)hipGetLastError(); grid = -1; return; }
        grid = cus;
    }
    if (grid < 0) return;
    if (hipMemsetAsync((char*)d_ws + WS_CTL, 0, CTL_ZERO_BYTES, stream) != hipSuccess) { fprintf(stderr, "kernel_launch: hipMemsetAsync failed\n"); return; }
    Args a{};
    for (int i = 0; i < 17; ++i) a.in[i] = (const float*)d_in[i];
    a.out = (float*)d_out; a.ws = (unsigned char*)d_ws;
    hipLaunchKernelGGL(hymba_fwd, dim3(grid), dim3(NWAVES * 64), LDS_BYTES, stream, a);
    const hipError_t le = hipPeekAtLastError();
    if (le != hipSuccess) fprintf(stderr, "kernel_launch: launch failed: %s\n", hipGetErrorName(le));
}
```

```cpp
#include <hip/hip_runtime.h>
#include <cstdio>
#include <cstdint>
namespace pg8 {
#define PG8_LAS __attribute__((address_space(3)))
typedef unsigned short bf16_t;
typedef short bf16x8 __attribute__((ext_vector_type(8)));
typedef float f32x4 __attribute__((ext_vector_type(4)));
typedef unsigned u32x4 __attribute__((ext_vector_type(4)));
constexpr int BM = 256, BK = 64, HALF = 128, HTB = HALF * BK * 2  , STAGE_BYTES = 8 * HTB, NXCD = 8, WGM = 8;

__host__ __device__ __forceinline__ int lds_byte(int r, int c) { const int st = (r >> 4) * 2 + (c >> 5), rr = r & 15, cc = c & 31, ob = rr * 64 + cc * 2; return st * 1024 + (ob ^ (((ob >> 9) & 1) << 5)); }
__host__ __device__ __forceinline__ void stage_rc(int b, int& R, int& C) { const int st = b / 1024, sb = b % 1024, swz = sb ^ (((sb >> 9) & 1) << 5); R = (st >> 1) * 16 + swz / 64; C = (st & 1) * 32 + (swz % 64) / 2; }
__host__ __device__ __forceinline__ int perm32(int rho) { const int n = rho >> 4, i = rho & 15; return 8 * (i >> 2) + 4 * n + (i & 3); }

struct Unit { int pm, pn; };
struct Gemm { const bf16_t* A; const bf16_t* Bt; int M, N, K; };

struct StaticOrder {
    int nM, nN, nwg, G, c;
    __host__ __device__ void init(int M, int N, int G_, int c_) { nM = M / BM; nN = N / BM; nwg = nM * nN; G = G_; c = c_; }
    __host__ __device__ bool next(int i, Unit& u) const {
        const long L = (long)i * G + c; if (L >= nwg) return false;
        int wgid = (int)L; { const int q = nwg / NXCD, r = nwg % NXCD, xcd = wgid % NXCD, off = wgid / NXCD; wgid = (xcd < r ? xcd * (q + 1) : r * (q + 1) + (xcd - r) * q) + off; }
        const int nig = WGM * nN, gid = wgid / nig, fm = gid * WGM, gsz = (nM - fm) < WGM ? (nM - fm) : WGM;
        u.pm = fm + ((wgid % nig) % gsz); u.pn = (wgid % nig) / gsz; return true;
    }
    __device__ __forceinline__ void a_ready(const Unit&) const {}
    __device__ __forceinline__ void done(const Unit&) const {}
};

__device__ __forceinline__ unsigned cvt_pk_bf16(float lo, float hi) { unsigned r; asm volatile("v_cvt_pk_bf16_f32 %0, %1, %2" : "=v"(r) : "v"(lo), "v"(hi)); return r; }
typedef float f32x2 __attribute__((ext_vector_type(2)));
__device__ __forceinline__ float silu_f(float g) { return g * __builtin_amdgcn_rcpf(1.0f + __builtin_amdgcn_exp2f(-1.4426950408889634f * g)); }

struct EpiSwiglu {
    static constexpr bool PERM = true, AFTER_DRAIN = false;
    bf16_t* O; int ldc;
    __device__ __forceinline__ void operator()(const f32x4 (&acc)[2][2][4][2], const Unit& u, int wr, int wc, int fr, int fq) const {
        const int row0 = u.pm * BM + wr * 64 + fr, col0 = u.pn * HALF + wc * 32 + 8 * fq;
#pragma unroll
        for (int ai = 0; ai < 2; ++ai)
#pragma unroll
            for (int m = 0; m < 4; ++m) { bf16_t* rowp = O + (size_t)(row0 + ai * HALF + m * 16) * ldc + col0;
                const f32x4 g0 = acc[ai][0][m][0], g1 = acc[ai][0][m][1], u0 = acc[ai][1][m][0], u1 = acc[ai][1][m][1];
                f32x4 v0, v1;
#pragma unroll
                for (int j = 0; j < 4; ++j) { v0[j] = silu_f(g0[j]) * u0[j]; v1[j] = silu_f(g1[j]) * u1[j]; }
                u32x4 w; w.x = cvt_pk_bf16(v0[0], v0[1]); w.y = cvt_pk_bf16(v0[2], v0[3]); w.z = cvt_pk_bf16(v1[0], v1[1]); w.w = cvt_pk_bf16(v1[2], v1[3]);
                *(u32x4*)rowp = w; }
    }
};

struct EpiResGate {
    static constexpr bool PERM = false, AFTER_DRAIN = false;
    const float* base; float* out; int ldc; const float* gate; int gstride; int rows_per_batch; float gs;
    __device__ __forceinline__ void operator()(const f32x4 (&acc)[2][2][4][2], const Unit& u, int wr, int wc, int fr, int fq) const {
        const int row0 = u.pm * BM + wr * 64 + fr, col0 = u.pn * BM + wc * 32 + 4 * fq;
        const float* gb = gate + (size_t)((u.pm * BM) / rows_per_batch) * gstride + col0;
        f32x4 gv[2][2];
#pragma unroll
        for (int bj = 0; bj < 2; ++bj)
#pragma unroll
            for (int n = 0; n < 2; ++n) gv[bj][n] = *(const f32x4*)(gb + bj * HALF + n * 16) * gs;
#pragma unroll
        for (int ai = 0; ai < 2; ++ai)
#pragma unroll
            for (int m = 0; m < 4; ++m) { const size_t off = (size_t)(row0 + ai * HALF + m * 16) * ldc + col0;
#pragma unroll
                for (int bj = 0; bj < 2; ++bj)
#pragma unroll
                    for (int n = 0; n < 2; ++n) { const f32x4 bs = *(const f32x4*)(base + off + bj * HALF + n * 16); *(f32x4*)(out + off + bj * HALF + n * 16) = bs + gv[bj][n] * acc[ai][bj][m][n]; } }
    }
};

struct EpiMix {
    static constexpr bool PERM = true, AFTER_DRAIN = false;
    bf16_t* Y; bf16_t* MIXB; size_t mix_stride; float* GATES; float qscale;
    __device__ __forceinline__ void operator()(const f32x4 (&acc)[2][2][4][2], const Unit& u, int wr, int wc, int fr, int fq) const {
        const int row0 = u.pm * BM + wr * 64 + fr;
        if (u.pn == 14) {
            if (wc == 0 && fq < 2) {
#pragma unroll
                for (int ai = 0; ai < 2; ++ai)
#pragma unroll
                    for (int m = 0; m < 4; ++m) { float* gp = GATES + (size_t)(row0 + ai * HALF + m * 16) * 16 + 8 * fq;
                        *(f32x4*)gp = acc[ai][0][m][0]; *(f32x4*)(gp + 4) = acc[ai][0][m][1]; }
            }
            return;
        }
        const int t = u.pn >> 1; const int col0 = (u.pn & 1) * BM + wc * 32 + 8 * fq;
        bf16_t* base; int ldc; float sc;
        if (t == 0) { base = Y; ldc = 1024; sc = qscale; } else { base = MIXB + (size_t)(t - 1) * mix_stride; ldc = 512; sc = 1.0f; }
#pragma unroll
        for (int ai = 0; ai < 2; ++ai)
#pragma unroll
            for (int m = 0; m < 4; ++m) { bf16_t* rowp = base + (size_t)(row0 + ai * HALF + m * 16) * ldc + col0;
#pragma unroll
                for (int bj = 0; bj < 2; ++bj) { const f32x4 v0 = acc[ai][bj][m][0] * sc, v1 = acc[ai][bj][m][1] * sc;
                    u32x4 w; w.x = cvt_pk_bf16(v0[0], v0[1]); w.y = cvt_pk_bf16(v0[2], v0[3]); w.z = cvt_pk_bf16(v1[0], v1[1]); w.w = cvt_pk_bf16(v1[2], v1[3]);
                    *(u32x4*)(rowp + bj * HALF) = w; } }
    }
};

template <class Epi, class Sched, bool ALIGN_EPI = false, bool SP2 = false>
__device__ __forceinline__ void gemm_phase(PG8_LAS unsigned char* lds, const Gemm g, const Sched& S, const Epi& E) {
    int tid_ = threadIdx.x; asm volatile("" : "+v"(tid_));
    const int tid = tid_, wid = __builtin_amdgcn_readfirstlane(tid >> 6), lane = tid & 63, wr = wid >> 2, wc = wid & 3, fr = lane & 15, fq = lane >> 4;
    const int K = g.K, nt = K / BK;
    unsigned voffA[2], voffB[2];
#pragma unroll
    for (int i = 0; i < 2; ++i) { int R, C; stage_rc(tid * 16 + i * 8192, R, C); const int Rb = Epi::PERM ? ((R & ~31) + perm32(R & 31)) : R;
        voffA[i] = (unsigned)(R * K + C) * 2u; voffB[i] = (unsigned)(Rb * K + C) * 2u; }
    const size_t kstep = (size_t)(BK * 2);
    const size_t hstep = (size_t)HALF * K * 2;
    const size_t tstep = 2 * hstep;
    const unsigned ldsw = (unsigned)wid * 1024u;
    const int aoff = lds_byte(wr * 64 + fr, fq * 8), boff = lds_byte(wc * 32 + fr, fq * 8);
#define PG8_SA(b, h) (((b) * 2 + (h)) * HTB)
#define PG8_SB(b, h) ((4 + (b) * 2 + (h)) * HTB)
#define PG8_STAGE(bufoff, gbase, voff) do { _Pragma("unroll") for (int _i = 0; _i < 2; ++_i) \
        __builtin_amdgcn_global_load_lds((const unsigned*)((const char*)(gbase) + (voff)[_i]), (PG8_LAS unsigned*)(lds + (bufoff) + ldsw + _i * 8192), 16, 0, 0); } while (0)
#define PG8_LDA(dst, b, h) do { _Pragma("unroll") for (int m = 0; m < 4; ++m) _Pragma("unroll") for (int k = 0; k < 2; ++k) dst[m][k] = *(const PG8_LAS bf16x8*)(lds + PG8_SA(b, h) + aoff + m * 2048 + k * 1024); } while (0)
#define PG8_LDB(dst, b, h) do { _Pragma("unroll") for (int n = 0; n < 2; ++n) _Pragma("unroll") for (int k = 0; k < 2; ++k) dst[n][k] = *(const PG8_LAS bf16x8*)(lds + PG8_SB(b, h) + boff + n * 2048 + k * 1024); } while (0)
#define PG8_MMA(ai, bj, At, Bt) do { __builtin_amdgcn_s_setprio(1); _Pragma("unroll") for (int m = 0; m < 4; ++m) _Pragma("unroll") for (int n = 0; n < 2; ++n) _Pragma("unroll") for (int k = 0; k < 2; ++k) \
        acc[ai][bj][m][n] = __builtin_amdgcn_mfma_f32_16x16x32_bf16(Bt[n][k], At[m][k], acc[ai][bj][m][n], 0, 0, 0); __builtin_amdgcn_s_setprio(0); } while (0)
#define PG8_WAIT_V(n) asm volatile("s_waitcnt vmcnt(" #n ")" ::: "memory")
#define PG8_WAIT_L(n) asm volatile("s_waitcnt lgkmcnt(" #n ")" ::: "memory")
#define PG8_BAR __builtin_amdgcn_s_barrier()
#define PG8_SCHED __builtin_amdgcn_sched_barrier(0)
    Unit cur, nxt; int ui = 0;
    if (!S.next(0, cur)) return;
    f32x4 acc[2][2][4][2];
#pragma unroll
    for (int a = 0; a < 2; ++a)
#pragma unroll
        for (int b = 0; b < 2; ++b)
#pragma unroll
            for (int m = 0; m < 4; ++m)
#pragma unroll
                for (int n = 0; n < 2; ++n) acc[a][b][m][n] = (f32x4){0.f, 0.f, 0.f, 0.f};
    bf16x8 At[4][2], B0[2][2], B1[2][2];
    const char* cA = (const char*)g.A + (size_t)cur.pm * tstep; const char* cB = (const char*)g.Bt + (size_t)cur.pn * tstep;
    S.a_ready(cur);
    if constexpr (SP2) {
        PG8_STAGE(PG8_SB(0, 0), cB, voffB); PG8_STAGE(PG8_SB(0, 1), cB + hstep, voffB); PG8_STAGE(PG8_SA(0, 0), cA, voffA); PG8_STAGE(PG8_SA(0, 1), cA + hstep, voffA);
        if (wr == 1) PG8_BAR;
        PG8_WAIT_V(2); PG8_BAR;
        PG8_STAGE(PG8_SB(1, 0), cB + kstep, voffB); PG8_STAGE(PG8_SA(1, 0), cA + kstep, voffA); PG8_STAGE(PG8_SB(1, 1), cB + hstep + kstep, voffB);
        PG8_WAIT_V(6); PG8_BAR;
    } else {
        PG8_STAGE(PG8_SB(0, 0), cB, voffB); PG8_STAGE(PG8_SA(0, 0), cA, voffA); PG8_STAGE(PG8_SB(0, 1), cB + hstep, voffB); PG8_STAGE(PG8_SA(0, 1), cA + hstep, voffA);
        if (wr == 1) PG8_BAR;
        PG8_WAIT_V(4); PG8_BAR;
        PG8_STAGE(PG8_SB(1, 0), cB + kstep, voffB); PG8_STAGE(PG8_SA(1, 0), cA + kstep, voffA); PG8_STAGE(PG8_SB(1, 1), cB + hstep + kstep, voffB);
        PG8_WAIT_V(6); PG8_BAR;
    }
    for (;;) {
        const bool has_next = S.next(ui + 1, nxt);
        const char* nA = has_next ? (const char*)g.A + (size_t)nxt.pm * tstep : cA; const char* nB = has_next ? (const char*)g.Bt + (size_t)nxt.pn * tstep : cB;
        for (int t = 0; t < nt; t += 2) {
            const bool last = (t == nt - 2);
            const char* a1 = cA + (size_t)(t + 1) * kstep;
            const char* a2 = last ? nA : cA + (size_t)(t + 2) * kstep; const char* b2 = last ? nB : cB + (size_t)(t + 2) * kstep;
            const char* a3 = a2 + kstep; const char* b3 = b2 + kstep;
            if (last && has_next) S.a_ready(nxt);
            if constexpr (SP2) {
            PG8_LDB(B0, 0, 0); PG8_LDB(B1, 0, 1); PG8_SCHED; PG8_LDA(At, 0, 0); PG8_STAGE(PG8_SA(1, 1), a1 + hstep, voffA);
            PG8_WAIT_V(8); PG8_WAIT_L(0); PG8_BAR; PG8_MMA(0, 0, At, B0); PG8_MMA(0, 1, At, B1); PG8_BAR; PG8_SCHED;
            PG8_LDA(At, 0, 1); PG8_STAGE(PG8_SB(0, 0), b2, voffB); PG8_STAGE(PG8_SB(0, 1), b2 + hstep, voffB); PG8_STAGE(PG8_SA(0, 0), a2, voffA);
            PG8_WAIT_V(8); PG8_WAIT_L(0); PG8_BAR; PG8_MMA(1, 0, At, B0); PG8_MMA(1, 1, At, B1); PG8_BAR; PG8_SCHED;
            PG8_LDB(B0, 1, 0); PG8_LDB(B1, 1, 1); PG8_SCHED; PG8_LDA(At, 1, 0); PG8_STAGE(PG8_SA(0, 1), a2 + hstep, voffA);
            PG8_WAIT_V(8); PG8_WAIT_L(0); PG8_BAR; PG8_MMA(0, 0, At, B0); PG8_MMA(0, 1, At, B1); PG8_BAR; PG8_SCHED;
            PG8_LDA(At, 1, 1); PG8_STAGE(PG8_SB(1, 0), b3, voffB); PG8_STAGE(PG8_SB(1, 1), b3 + hstep, voffB); PG8_STAGE(PG8_SA(1, 0), a3, voffA);
            PG8_WAIT_V(8); PG8_WAIT_L(0); PG8_BAR; PG8_MMA(1, 0, At, B0); PG8_MMA(1, 1, At, B1); PG8_BAR; PG8_SCHED;
            } else {
            PG8_LDB(B0, 0, 0); PG8_SCHED; PG8_LDA(At, 0, 0); PG8_STAGE(PG8_SA(1, 1), a1 + hstep, voffA);
            PG8_WAIT_L(8); PG8_BAR; PG8_WAIT_L(0); PG8_MMA(0, 0, At, B0); PG8_BAR; PG8_SCHED;
            PG8_LDB(B1, 0, 1); PG8_STAGE(PG8_SB(0, 0), b2, voffB);
            PG8_BAR; PG8_WAIT_L(0); PG8_MMA(0, 1, At, B1); PG8_BAR;
            PG8_LDA(At, 0, 1); PG8_STAGE(PG8_SA(0, 0), a2, voffA);
            PG8_BAR; PG8_WAIT_L(0); PG8_MMA(1, 0, At, B0); PG8_BAR; PG8_SCHED;
            PG8_STAGE(PG8_SB(0, 1), b2 + hstep, voffB);
            PG8_WAIT_V(6); PG8_BAR; PG8_MMA(1, 1, At, B1); PG8_BAR;
            PG8_LDB(B0, 1, 0); PG8_SCHED; PG8_LDA(At, 1, 0); PG8_STAGE(PG8_SA(0, 1), a2 + hstep, voffA);
            PG8_WAIT_L(8); PG8_BAR; PG8_WAIT_L(0); PG8_MMA(0, 0, At, B0); PG8_BAR; PG8_SCHED;
            PG8_LDB(B1, 1, 1); PG8_STAGE(PG8_SB(1, 0), b3, voffB);
            PG8_BAR; PG8_WAIT_L(0); PG8_MMA(0, 1, At, B1); PG8_BAR;
            PG8_LDA(At, 1, 1); PG8_STAGE(PG8_SA(1, 0), a3, voffA);
            PG8_BAR; PG8_WAIT_L(0); PG8_MMA(1, 0, At, B0); PG8_BAR; PG8_SCHED;
            PG8_STAGE(PG8_SB(1, 1), b3 + hstep, voffB);
            PG8_WAIT_V(6); PG8_BAR; PG8_MMA(1, 1, At, B1); PG8_BAR;
            }
        }
        if constexpr (ALIGN_EPI) { if (wr == 0) PG8_BAR; }
        if constexpr (!Epi::AFTER_DRAIN) { E(acc, cur, wr, wc, fr, fq); S.done(cur); }
        if (!has_next) break;
#pragma unroll
        for (int a = 0; a < 2; ++a)
#pragma unroll
            for (int b = 0; b < 2; ++b)
#pragma unroll
                for (int m = 0; m < 4; ++m)
#pragma unroll
                    for (int n = 0; n < 2; ++n) acc[a][b][m][n] = (f32x4){0.f, 0.f, 0.f, 0.f};
        cur = nxt; cA = nA; cB = nB; ++ui;
        if constexpr (ALIGN_EPI) { if (wr == 1) PG8_BAR; }
    }
    PG8_WAIT_V(0);
    if constexpr (!ALIGN_EPI) { if (wr == 0) PG8_BAR; }
    PG8_BAR;
    if constexpr (Epi::AFTER_DRAIN) { E.fused(acc, cur, wr, wc, fr, fq, lds, wid, lane); S.done(cur); }
#undef PG8_SA
#undef PG8_SB
#undef PG8_STAGE
#undef PG8_LDA
#undef PG8_LDB
#undef PG8_MMA
#undef PG8_WAIT_V
#undef PG8_WAIT_L
#undef PG8_BAR
#undef PG8_SCHED
}
}
constexpr int NWAVES = 8;
constexpr int BATCH = 4, SEQ = 4096, D = 1024, FF = 2816, NMOD = 9 * D;
constexpr int M = BATCH * SEQ;
constexpr int MIXN = 3600;
constexpr int MIXNP = 3840;
constexpr float EPS = 1e-6f;
constexpr float QSCALE = 0.125f * 1.4426950408889634f;

constexpr size_t MiB = 1u << 20;
constexpr size_t WS_CTL = 0, CTL_ZERO_BYTES = 1 * MiB;
constexpr size_t WS_MOD = 1 * MiB, WS_GATES = 2 * MiB;
constexpr size_t WS_W1I = 4 * MiB, WS_W1O = 15 * MiB, WS_WMI = 21 * MiB, WS_WMO = 29 * MiB, WS_W2I = 31 * MiB, WS_W2O = 42 * MiB;
constexpr size_t WS_XN = 48 * MiB;
constexpr size_t WS_Y = 80 * MiB;
constexpr size_t WS_ACT = 112 * MiB;
constexpr size_t WS_QC = 208 * MiB, WS_KC = 224 * MiB;
constexpr size_t WS_MS = 240 * MiB, WS_DEC = 242 * MiB, WS_CB = 3 * MiB, WS_CT = 3 * MiB + 768 * 1024;
constexpr size_t WS_END = 243 * MiB;
static_assert(WS_W1I + (size_t)2 * FF * D * 2 <= WS_W1O && WS_W1O + (size_t)D * FF * 2 <= WS_WMI && WS_WMI + (size_t)MIXNP * D * 2 <= WS_WMO && WS_WMO + (size_t)D * D * 2 <= WS_W2I &&
              WS_W2I + (size_t)2 * FF * D * 2 <= WS_W2O && WS_W2O + (size_t)D * FF * 2 <= WS_XN && WS_XN + (size_t)M * D * 2 <= WS_Y && WS_Y + (size_t)M * D * 2 <= WS_ACT &&
              WS_ACT + (size_t)6 * M * 512 * 2 <= WS_QC && WS_ACT + (size_t)M * FF * 2 <= WS_QC && WS_MS + (size_t)16 * 5 * SEQ * 4 <= WS_DEC && WS_CB + (size_t)32 * SEQ * 4 <= WS_W1I && WS_MOD + (size_t)BATCH * NMOD * 4 <= WS_GATES && WS_GATES + (size_t)M * 16 * 4 <= WS_W1I, "d_ws map");
constexpr int CW_QUEUE = 64;
constexpr int CW_BAR = 4096;

constexpr int RING_OFF = 0, RING_BYTES = 131072;
constexpr int LDSCTL_OFF = RING_BYTES, MISC_OFF = LDSCTL_OFF + 320;
constexpr int LDS_BYTES = 147456;
static_assert(MISC_OFF + 128 <= LDS_BYTES, "LDS map");

#include <hip/hip_bf16.h>
#include <cmath>
namespace attn_body {
using bf16=__hip_bfloat16;
using bf16x8=__attribute__((ext_vector_type(8)))short;
using s16x4=__attribute__((ext_vector_type(4)))short;
using f32x16=__attribute__((ext_vector_type(16)))float;
using u32x4=__attribute__((ext_vector_type(4)))unsigned;
constexpr int BATCH=4,NHEAD=8,SEQ=4096,D=64,DM=1024,DKV=512;
constexpr int NW=8,QBLK=32,QB=QBLK*NW,KVBLK=64,NQB=SEQ/QB;
constexpr int ATTN_UNIT_ROWS=QB;
__device__ __forceinline__ int crow(int r,int hi){return (r&3)+8*(r>>2)+4*hi;}
#define SBAR() __builtin_amdgcn_sched_barrier(0)
__device__ __forceinline__ void cmask(f32x16&p0,f32x16&p1,int jb,int qrel,int hi){
  const float NEG=-INFINITY; int kb=64*jb+4*hi;
  #pragma unroll
  for(int r=0;r<16;++r){int kv=kb+(r&3)+8*(r>>2); if(kv>qrel)p0[r]=NEG; if(kv+32>qrel)p1[r]=NEG;}
}

constexpr int NSLOT=3, SLOTB=8192;
constexpr int LDS_K=0, LDS_V=NSLOT*SLOTB, LDS_WS=2*NSLOT*SLOTB, LDS_OST=LDS_WS+NW*64*4, LDS_BYTES=LDS_OST+NW*4096;
constexpr float C2=0.125f*1.4426950408889634f;
__device__ __forceinline__ void glds16(const void*gsrc,unsigned lds_dst){unsigned keep;
  asm volatile("s_mov_b32 %0, m0\n\ts_mov_b32 m0, %2\n\ts_nop 0\n\tglobal_load_lds_dwordx4 %1, off\n\ts_mov_b32 m0, %0":"=&s"(keep):"v"(gsrc),"s"(lds_dst):"memory");}
__device__ __forceinline__ float max3f(float a,float b,float c){float r;asm("v_max3_f32 %0, %1, %2, %3":"=v"(r):"v"(a),"v"(b),"v"(c));return r;}
__device__ __forceinline__ float max2f(float a,float b){float r;asm("v_max_f32_e32 %0, %1, %2":"=v"(r):"v"(a),"v"(b));return r;}
__device__ __forceinline__ float fadd_s(float a,float b){float r;asm("v_add_f32_e32 %0, %1, %2":"=v"(r):"v"(a),"v"(b));return r;}
__device__ __forceinline__ float fsub_s(float a,float b){float r;asm("v_sub_f32_e32 %0, %1, %2":"=v"(r):"v"(a),"v"(b));return r;}
typedef float f32x2_t __attribute__((ext_vector_type(2))); typedef __bf16 bf16x2_t __attribute__((ext_vector_type(2)));
__device__ __forceinline__ unsigned cvtpk_s(float lo,float hi){f32x2_t v={lo,hi};bf16x2_t b=__builtin_convertvector(v,bf16x2_t);return __builtin_bit_cast(unsigned,b);}
#define WAIT_BAR(N) asm volatile("s_waitcnt vmcnt(" #N ") lgkmcnt(0)\n\ts_barrier":::"memory")

__device__ __forceinline__ void qkt(f32x16&p0,f32x16&p1,const char*Kslot,const bf16x8*qr,int r32,int hi){
  const char*kb=Kslot+hi*1024+r32*16;
  #pragma unroll
  for(int d0=0;d0<4;++d0){
    const bf16x8 b0=*reinterpret_cast<const bf16x8*>(kb+d0*2048);
    const bf16x8 b1=*reinterpret_cast<const bf16x8*>(kb+d0*2048+512);
    {p0=__builtin_amdgcn_mfma_f32_32x32x16_bf16(b0,qr[d0],p0,0,0,0);p1=__builtin_amdgcn_mfma_f32_32x32x16_bf16(b1,qr[d0],p1,0,0,0);}}
}
typedef __attribute__((address_space(3))) const char* lds_cptr;
typedef short v4i16_t __attribute__((ext_vector_type(4)));
__device__ __forceinline__ void kload8(bf16x8*kf,lds_cptr kp){
  kf[0]=*(const __attribute__((address_space(3))) bf16x8*)(kp);      kf[1]=*(const __attribute__((address_space(3))) bf16x8*)(kp+512);
  kf[2]=*(const __attribute__((address_space(3))) bf16x8*)(kp+2048); kf[3]=*(const __attribute__((address_space(3))) bf16x8*)(kp+2560);
  kf[4]=*(const __attribute__((address_space(3))) bf16x8*)(kp+4096); kf[5]=*(const __attribute__((address_space(3))) bf16x8*)(kp+4608);
  kf[6]=*(const __attribute__((address_space(3))) bf16x8*)(kp+6144); kf[7]=*(const __attribute__((address_space(3))) bf16x8*)(kp+6656);
}
__device__ __forceinline__ void kload2(bf16x8*kf,lds_cptr kp,int j){ kf[2*j]=*(const __attribute__((address_space(3))) bf16x8*)(kp+j*2048); kf[2*j+1]=*(const __attribute__((address_space(3))) bf16x8*)(kp+j*2048+512); }
__device__ __forceinline__ s16x4 vtr(lds_cptr p){ return __builtin_bit_cast(s16x4,__builtin_amdgcn_ds_read_tr16_b64_v4i16((__attribute__((address_space(3))) v4i16_t*)p)); }
__device__ __forceinline__ float rowmax(const f32x16&p0,const f32x16&p1){
  float a=max3f(p0[0],p0[1],p1[0]),b=max3f(p0[2],p0[3],p1[1]);a=max3f(a,p1[2],p1[3]);
  #pragma unroll
  for(int r=4;r<16;r+=4){a=max3f(a,p0[r],p0[r+1]);b=max3f(b,p0[r+2],p0[r+3]);a=max3f(a,p1[r],p1[r+1]);b=max3f(b,p1[r+2],p1[r+3]);}
  const float m=max2f(a,b);
  auto rr=__builtin_amdgcn_permlane32_swap(__float_as_uint(m),__float_as_uint(m),false,false);
  return max2f(__uint_as_float(rr[0]),__uint_as_float(rr[1]));
}
__device__ __forceinline__ void pv(f32x16*o,int vb,bf16x8 pa0,bf16x8 pa1,bf16x8 pa2,bf16x8 pa3){
  #pragma unroll
  for(int d0=0;d0<2;++d0){s16x4 lo[4],hi[4];
    #pragma unroll
    for(int ks=0;ks<4;++ks){
      asm volatile("ds_read_b64_tr_b16 %0,%1 offset:%c2":"=&v"(lo[ks]):"v"(vb),"i"(d0*4096+ks*1024):"memory");
      asm volatile("ds_read_b64_tr_b16 %0,%1 offset:%c2":"=&v"(hi[ks]):"v"(vb),"i"(d0*4096+ks*1024+512):"memory");}
    asm volatile("s_waitcnt lgkmcnt(0)":::"memory");SBAR();
    #define PK(k) (bf16x8){lo[k][0],lo[k][1],lo[k][2],lo[k][3],hi[k][0],hi[k][1],hi[k][2],hi[k][3]}
    o[d0]=__builtin_amdgcn_mfma_f32_32x32x16_bf16(pa0,PK(0),o[d0],0,0,0);
    o[d0]=__builtin_amdgcn_mfma_f32_32x32x16_bf16(pa1,PK(1),o[d0],0,0,0);
    o[d0]=__builtin_amdgcn_mfma_f32_32x32x16_bf16(pa2,PK(2),o[d0],0,0,0);
    o[d0]=__builtin_amdgcn_mfma_f32_32x32x16_bf16(pa3,PK(3),o[d0],0,0,0);
    #undef PK
  }
}

#ifndef ATTN_STORE16
#define ATTN_STORE16(p,v) (*(u32x4*)(p)=(v))
#endif
typedef __attribute__((address_space(3))) const float* lds_fptr;
typedef float f32x4_t __attribute__((ext_vector_type(4)));
#define LDF4(p) (*(const __attribute__((address_space(3))) f32x4_t*)(p))
#define CINIT(C0,C1,t) do{ const lds_fptr cbt_=cbl+(t)*64+4*hi; const float nmh_=-mhat; \
    { const f32x4_t a0_=LDF4(cbt_),a1_=LDF4(cbt_+8),a2_=LDF4(cbt_+16),a3_=LDF4(cbt_+24); \
      C0=__builtin_shufflevector(__builtin_shufflevector(a0_,a1_,0,1,2,3,4,5,6,7),__builtin_shufflevector(a2_,a3_,0,1,2,3,4,5,6,7),0,1,2,3,4,5,6,7,8,9,10,11,12,13,14,15); } \
    { const f32x4_t a0_=LDF4(cbt_+32),a1_=LDF4(cbt_+40),a2_=LDF4(cbt_+48),a3_=LDF4(cbt_+56); \
      C1=__builtin_shufflevector(__builtin_shufflevector(a0_,a1_,0,1,2,3,4,5,6,7),__builtin_shufflevector(a2_,a3_,0,1,2,3,4,5,6,7),0,1,2,3,4,5,6,7,8,9,10,11,12,13,14,15); } \
    C0=nmh_-C0; C1=nmh_-C1; }while(0)
template<int THRL> __device__ __forceinline__ void attn_unit(int b,int h,int qb,const bf16*Q,const bf16*__restrict__ K,const bf16*__restrict__ V,bf16*O,char*shm,lds_fptr cbl){
  int tid_=threadIdx.x; asm volatile("":"+v"(tid_)); const int tid=tid_,lane=tid&63,r32=lane&31,hi=lane>>5; const int wid=__builtin_amdgcn_readfirstlane(tid>>6);
  const long rowbase=(long)b*SEQ; const int q0=qb*QB;
  const bf16*Qw=Q+(rowbase+q0+wid*QBLK)*DM+h*D;
  const bf16*Kh=K+rowbase*DKV+h*D,*Vh=V+rowbase*DKV+h*D;
  const unsigned lds0=(unsigned)(uintptr_t)shm;
  float*wsf=(float*)(shm+LDS_WS)+wid*64;
  const bf16*ksrc=Kh+(long)lane*DKV+wid*8;
  const bf16*vsrc=Vh+(long)(16*(wid&3)+(lane>>2))*DKV+(wid>>2)*32+(lane&3)*8;
  const unsigned kdst=lds0+LDS_K+wid*1024, vdst=lds0+LDS_V+wid*1024;
  #define DMA_K(t,slot) glds16(ksrc+(long)(t)*KVBLK*DKV,(unsigned)__builtin_amdgcn_readfirstlane(kdst+(slot)))
  #define DMA_V(t,slot) glds16(vsrc+(long)(t)*KVBLK*DKV,(unsigned)__builtin_amdgcn_readfirstlane(vdst+(slot)))
  const int vb0=(int)(lds0+LDS_V)+((lane>>4)&1)*32+(lane&3)*8+(4*hi+((lane&15)>>2))*64;
  const char*Kbase=shm+LDS_K; bf16x8 kf[8];
  const lds_cptr shm3=(lds_cptr)shm; const lds_cptr kp0=shm3+LDS_K+hi*1024+r32*16; const lds_cptr vp0=shm3+LDS_V+((lane>>4)&1)*32+(lane&3)*8+(4*hi+((lane&15)>>2))*64;
  const int NT=(q0+QB)/KVBLK;
  DMA_K(0,0);DMA_V(0,0);DMA_K(1,SLOTB);
  bf16x8 qr[4];
  #pragma unroll
  for(int d0=0;d0<4;++d0)qr[d0]=*reinterpret_cast<const bf16x8*>(&Qw[(long)r32*DM+d0*16+hi*8]);
  float mhat=0.f,l_reg=0.f;f32x16 o[2];o[0]=f32x16{};o[1]=f32x16{};
  const int qrel=wid*QBLK+r32;
  #define CMASK(P0,P1,t) do{int jb_=(t)-(NT-4); if(jb_>=0)cmask(P0,P1,jb_,qrel,hi);}while(0)
  bool resc=false;
  #define START(P0,P1) do{ const float rm=rowmax(P0,P1); resc=false; \
    { const float dl=rm; mhat=fadd_s(mhat,dl); \
      _Pragma("unroll") for(int r=0;r<16;++r){P0[r]=fsub_s(P0[r],dl);P1[r]=fsub_s(P1[r],dl);} \
      } \
    _Pragma("unroll") for(int r=0;r<16;++r)P0[r]=__builtin_amdgcn_exp2f(P0[r]); }while(0)
  #define RESC() do{ if(resc){ asm volatile("s_waitcnt lgkmcnt(0)":::"memory"); \
      _Pragma("unroll") for(int d_=0;d_<2;++d_) _Pragma("unroll") for(int r=0;r<16;++r)o[d_][r]*=wsf[crow(r,hi)]; } }while(0)
  f32x16 pA0,pA1,pB0,pB1;
  int sl_prev=0,sl_cur=0,sl_next=SLOTB;
  #define ROT() do{sl_prev=sl_cur;sl_cur=sl_next;sl_next=(sl_next==(NSLOT-1)*SLOTB)?0:sl_next+SLOTB;}while(0)
  DMA_K(2,2*SLOTB);
  WAIT_BAR(3);
  CINIT(pA0,pA1,0); qkt(pA0,pA1,Kbase,qr,r32,hi);asm volatile("s_nop 15\n\ts_nop 7":"+v"(pA0),"+v"(pA1));CMASK(pA0,pA1,0);
  START(pA0,pA1);
  _Pragma("unroll") for(int r=0;r<16;++r)pA1[r]=__builtin_amdgcn_exp2f(pA1[r]);
  WAIT_BAR(0);
  DMA_K(3,0);DMA_V(1,SLOTB);
  ROT();
  kload8(kf,kp0+sl_cur);
  WAIT_BAR(2);
  s16x4 vlo[8],vhi[8]; u32x4 pw0,pw1,pw2,pw3;
  #define PKW(P,B) cvtpk_s(P[B],P[B+1])
  #define PAF(k) __builtin_bit_cast(bf16x8,pw##k)
  #define VFR(i) (bf16x8){vlo[i][0],vlo[i][1],vlo[i][2],vlo[i][3],vhi[i][0],vhi[i][1],vhi[i][2],vhi[i][3]}
  #define PIN(x) asm volatile("":"+v"(x))
  #define MX3(a,b,c) __builtin_fmaxf(__builtin_fmaxf((a),(b)),(c))
  #define GAPA(MF,A0,A1,A2,A3,W0,W1,PW) do{ MF; sacc+=A0; sacc+=A1; sacc+=A2; sacc+=A3; PIN(sacc); W0; W1; PIN(PW); SBAR(); }while(0)
  #define EX(v) __builtin_amdgcn_exp2f(v)
  #define GAPB(MF,X,B) do{ MF; X[B]=EX(X[B]); X[B+1]=EX(X[B+1]); X[B+2]=EX(X[B+2]); X[B+3]=EX(X[B+3]); PIN(X); SBAR(); }while(0)
  #define VRD(i) do{ vlo[i]=vtr(vp_+(((i)>>2)*4096+((i)&3)*1024)); vhi[i]=vtr(vp_+(((i)>>2)*4096+((i)&3)*1024+512)); }while(0)
  #define KRD(G,j) do{ if(G){ kload2(kf,kp0+sl_next,j); SBAR(); } }while(0)
  #define STEP(C0,C1,P0,P1,t,GK,GV,GL) do{ SBAR(); \
    CINIT(C0,C1,t); SBAR(); \
    const lds_cptr vp_=vp0+sl_prev; \
    VRD(0); SBAR(); float sacc=(P0[0]+P0[1]); \
    GAPA(C0=__builtin_amdgcn_mfma_f32_32x32x16_bf16(kf[0],qr[0],C0,0,0,0), P0[2],P0[3],P0[4],P0[5],     pw0[0]=PKW(P0,0), pw0[1]=PKW(P0,2), pw0); \
    VRD(4); SBAR(); GAPA(C1=__builtin_amdgcn_mfma_f32_32x32x16_bf16(kf[1],qr[0],C1,0,0,0), P0[6],P0[7],P0[8],P0[9],     pw0[2]=PKW(P0,4), pw0[3]=PKW(P0,6), pw0); \
    VRD(1); SBAR(); GAPA(C0=__builtin_amdgcn_mfma_f32_32x32x16_bf16(kf[2],qr[1],C0,0,0,0),   P0[10],P0[11],P0[12],P0[13], pw1[0]=PKW(P0,8), pw1[1]=PKW(P0,10), pw1); \
    VRD(5); SBAR(); GAPA(C1=__builtin_amdgcn_mfma_f32_32x32x16_bf16(kf[3],qr[1],C1,0,0,0),   P0[14],P0[15],P1[0],P1[1],   pw1[2]=PKW(P0,12),pw1[3]=PKW(P0,14), pw1); \
    VRD(2); SBAR(); GAPA(C0=__builtin_amdgcn_mfma_f32_32x32x16_bf16(kf[4],qr[2],C0,0,0,0),   P1[2],P1[3],P1[4],P1[5],     pw2[0]=PKW(P1,0), pw2[1]=PKW(P1,2), pw2); \
    VRD(6); SBAR(); GAPA(C1=__builtin_amdgcn_mfma_f32_32x32x16_bf16(kf[5],qr[2],C1,0,0,0),   P1[6],P1[7],P1[8],P1[9],     pw2[2]=PKW(P1,4), pw2[3]=PKW(P1,6), pw2); \
    VRD(3); SBAR(); GAPA(C0=__builtin_amdgcn_mfma_f32_32x32x16_bf16(kf[6],qr[3],C0,0,0,0),   P1[10],P1[11],P1[12],P1[13], pw3[0]=PKW(P1,8), pw3[1]=PKW(P1,10), pw3); \
    VRD(7); SBAR(); GAPA(C1=__builtin_amdgcn_mfma_f32_32x32x16_bf16(kf[7],qr[3],C1,0,0,0),   P1[14],P1[15],0.f,0.f,       pw3[2]=PKW(P1,12),pw3[3]=PKW(P1,14), pw3); \
    l_reg+=sacc; \
    if(GK){DMA_K((t)+3,sl_cur);} if(GV){DMA_V((t)+1,sl_next);} \
    CMASK(C0,C1,t); \
    { float a=MX3(C0[0],C0[1],C1[0]),b=MX3(C0[2],C0[3],C1[1]); a=MX3(a,C1[2],C1[3]); \
      _Pragma("unroll") for(int r=4;r<16;r+=4){a=MX3(a,C0[r],C0[r+1]);b=MX3(b,C0[r+2],C0[r+3]);a=MX3(a,C1[r],C1[r+1]);b=MX3(b,C1[r+2],C1[r+3]);} \
      float rm=__builtin_fmaxf(a,b); { auto rr=__builtin_amdgcn_permlane32_swap(__float_as_uint(rm),__float_as_uint(rm),false,false); rm=__builtin_fmaxf(__uint_as_float(rr[0]),__uint_as_float(rr[1])); } \
      resc=false; \
      if(__builtin_expect(__any(rm>(float)THRL),0)){ const float dl=__builtin_fmaxf(rm,0.f); mhat+=dl; \
        _Pragma("unroll") for(int r=0;r<16;++r){C0[r]-=dl;C1[r]-=dl;} \
        const float f=__builtin_amdgcn_exp2f(-dl); l_reg*=f; if(hi==0)wsf[r32]=f; resc=true; } } \
    SBAR(); \
    GAPB(o[0]=__builtin_amdgcn_mfma_f32_32x32x16_bf16(PAF(0),VFR(0),o[0],0,0,0), C0,0); \
    GAPB(o[1]=__builtin_amdgcn_mfma_f32_32x32x16_bf16(PAF(0),VFR(4),o[1],0,0,0), C0,4); \
    KRD(GL,0); GAPB(o[0]=__builtin_amdgcn_mfma_f32_32x32x16_bf16(PAF(1),VFR(1),o[0],0,0,0), C0,8); \
    KRD(GL,1); GAPB(o[1]=__builtin_amdgcn_mfma_f32_32x32x16_bf16(PAF(1),VFR(5),o[1],0,0,0), C0,12); \
    KRD(GL,2); GAPB(o[0]=__builtin_amdgcn_mfma_f32_32x32x16_bf16(PAF(2),VFR(2),o[0],0,0,0), C1,0); \
    KRD(GL,3); GAPB(o[1]=__builtin_amdgcn_mfma_f32_32x32x16_bf16(PAF(2),VFR(6),o[1],0,0,0), C1,4); \
    GAPB(o[0]=__builtin_amdgcn_mfma_f32_32x32x16_bf16(PAF(3),VFR(3),o[0],0,0,0), C1,8); \
    GAPB(o[1]=__builtin_amdgcn_mfma_f32_32x32x16_bf16(PAF(3),VFR(7),o[1],0,0,0), C1,12); \
    }while(0)
  int t=1;
  #undef CMASK
  #define CMASK(P0,P1,t) do{}while(0)
  for(;t+5<NT;t+=2){
    STEP(pB0,pB1,pA0,pA1,t,true,true,true);     WAIT_BAR(2); RESC(); ROT();
    STEP(pA0,pA1,pB0,pB1,t+1,true,true,true);   WAIT_BAR(2); RESC(); ROT();
  }
  #undef CMASK
  #define CMASK(P0,P1,t) do{int jb_=(t)-(NT-4); if(jb_>=0)cmask(P0,P1,jb_,qrel,hi);}while(0)
  #define ENDW(tt) do{ if((tt)+3<NT){WAIT_BAR(2);} else if((tt)+2<NT){WAIT_BAR(1);} else {WAIT_BAR(0);} }while(0)
  for(;t+1<NT;t+=2){
    STEP(pB0,pB1,pA0,pA1,t,(t+3<NT),(t+1<NT),(t+1<NT));       ENDW(t);   RESC(); ROT();
    STEP(pA0,pA1,pB0,pB1,t+1,(t+4<NT),(t+2<NT),(t+2<NT));     ENDW(t+1); RESC(); ROT();
  }
  STEP(pB0,pB1,pA0,pA1,NT-1,false,false,false); RESC();
  { float sacc=pB0[0]+pB0[1]; _Pragma("unroll") for(int r=2;r<16;++r)sacc+=pB0[r]; _Pragma("unroll") for(int r=0;r<16;++r)sacc+=pB1[r]; l_reg+=sacc;
    pw0=(u32x4){PKW(pB0,0),PKW(pB0,2),PKW(pB0,4),PKW(pB0,6)};pw1=(u32x4){PKW(pB0,8),PKW(pB0,10),PKW(pB0,12),PKW(pB0,14)};pw2=(u32x4){PKW(pB1,0),PKW(pB1,2),PKW(pB1,4),PKW(pB1,6)};pw3=(u32x4){PKW(pB1,8),PKW(pB1,10),PKW(pB1,12),PKW(pB1,14)};
    SBAR(); pv(o,vb0+sl_cur,PAF(0),PAF(1),PAF(2),PAF(3)); }
  #undef PKW
  #undef PAF
  #undef VFR
  #undef PIN
  #undef MX3
  #undef GAPA
  #undef GAPB
  #undef EX
  #undef VRD
  #undef KRD
  #undef STEP
  #undef ENDW
  {auto rr=__builtin_amdgcn_permlane32_swap(__float_as_uint(l_reg),__float_as_uint(l_reg),false,false);l_reg=__uint_as_float(rr[0])+__uint_as_float(rr[1]);}
  if(hi==0)wsf[32+r32]=l_reg;asm volatile("s_waitcnt lgkmcnt(0)":::"memory");
  float rli[16];
  #pragma unroll
  for(int r=0;r<16;++r)rli[r]=__builtin_amdgcn_rcpf(wsf[32+crow(r,hi)]);
  bf16*Ow=O+(rowbase+q0+wid*QBLK)*DM+h*D;
  { bf16*stg=(bf16*)(shm+LDS_OST)+wid*2048;
    #pragma unroll
    for(int r=0;r<16;++r){const int orow=crow(r,hi);
      #pragma unroll
      for(int d0=0;d0<2;++d0)stg[orow*64+d0*32+r32]=__float2bfloat16(o[d0][r]*rli[r]);}
    asm volatile("s_waitcnt lgkmcnt(0)":::"memory");
    #pragma unroll
    for(int i=0;i<4;++i){const int row=i*8+(lane>>3),ch=lane&7; const u32x4 v=*(const u32x4*)(stg+row*64+ch*8); ATTN_STORE16(Ow+(long)row*DM+ch*8,v);} }
  asm volatile("s_waitcnt lgkmcnt(0)\n\ts_barrier":::"memory");
  #undef DMA_K
  #undef DMA_V
  #undef CMASK
  #undef START
  #undef RESC
  #undef ROT
}
constexpr int ATTN_LDS_BYTES=LDS_BYTES;
#undef CINIT
#undef LDF4
#undef SBAR
#undef WAIT_BAR
}
#define GAS __attribute__((address_space(1)))
#define LAS __attribute__((address_space(3)))
typedef unsigned short bf16;
typedef unsigned v4u __attribute__((ext_vector_type(4)));
typedef float f32x4 __attribute__((ext_vector_type(4)));
typedef short bf16x8 __attribute__((ext_vector_type(8)));
typedef GAS unsigned gu32;
typedef GAS unsigned long long gu64;
#define RLX_AGENT __ATOMIC_RELAXED, __HIP_MEMORY_SCOPE_AGENT
#define LDS_WAIT() asm volatile("s_waitcnt lgkmcnt(0)" ::: "memory")
#define VM_WAIT() asm volatile("s_waitcnt vmcnt(0)" ::: "memory")
__device__ __forceinline__ unsigned long long rt() { return __builtin_amdgcn_s_memrealtime(); }
__device__ __forceinline__ unsigned f2bf(float f) { unsigned u = __builtin_bit_cast(unsigned, f); return (u + 0x7fffu + ((u >> 16) & 1u)) >> 16; }
__device__ __forceinline__ unsigned pk2(float lo, float hi) { return f2bf(lo) | (f2bf(hi) << 16); }

#define XB_TMO      128
#define XB_XCNT(j)  (256  + 64 * (j))
#define XB_XSUB(j)  (1280 + 64 * (j))
#define XB_XGEN(j)  (2304 + 64 * (j))
#define XB_TOP      3328
#define XB_TOPGEN   3392
#define XCD_BAR_WORDS 3456
#define XB_SPIN_CAP (1u << 18)

__device__ __forceinline__ unsigned xb_ld(unsigned* p)              { return __hip_atomic_load(p, __ATOMIC_RELAXED, __HIP_MEMORY_SCOPE_AGENT); }
__device__ __forceinline__ unsigned xb_add(unsigned* p, unsigned v) { return __hip_atomic_fetch_add(p, v, __ATOMIC_RELAXED, __HIP_MEMORY_SCOPE_AGENT); }
__device__ __forceinline__ unsigned xb_xcc_id() { return (unsigned)__builtin_amdgcn_s_getreg((3 << 11) | 20) & 0xFu; }
#define XB_SPIN(cond, bar) do { unsigned _sp = 0; while (cond) { __builtin_amdgcn_s_sleep(1); \
    if ((++_sp & 255u) == 0u) { if (xb_ld(&(bar)[XB_TMO])) break; if (_sp > XB_SPIN_CAP) { atomicAdd(&(bar)[XB_TMO], 1u); break; } } } } while (0)

struct XcdBarrier {
    unsigned* bar; unsigned x;
    volatile LAS unsigned* st;
};

__device__ __forceinline__ XcdBarrier xcd_barrier_post(unsigned* bar, volatile LAS unsigned* st) {
    XcdBarrier b; b.bar = bar; b.x = xb_xcc_id(); b.st = st;
    if (threadIdx.x == 0) (void)xb_add(&bar[XB_XCNT(b.x)], 1u);
    return b;
}
__device__ __forceinline__ void xcd_barrier_complete(unsigned* bar, unsigned x, unsigned& nloc, unsigned& nx) {
    const unsigned G = gridDim.x * gridDim.y * gridDim.z;
    unsigned sum, cnt, mine, sp = 0u;
    for (;;) {
        sum = 0u; cnt = 0u; mine = 0u;
#pragma unroll
        for (unsigned j = 0; j < 16; ++j) { const unsigned c = xb_ld(&bar[XB_XCNT(j)]); sum += c; cnt += (c > 0u) ? 1u : 0u; mine = (j == x) ? c : mine; }
        if (sum == G) break;
        __builtin_amdgcn_s_sleep(1);
        if ((++sp & 255u) == 0u) { if (xb_ld(&bar[XB_TMO])) break; if (sp > XB_SPIN_CAP) { atomicAdd(&bar[XB_TMO], 1u); break; } }
    }
    nloc = mine > 0u ? mine : 1u; nx = cnt > 0u ? cnt : 1u;
}

__device__ __forceinline__ void xcd_barrier(const XcdBarrier& b) {
    asm volatile("s_waitcnt vmcnt(0)" ::: "memory");
    __syncthreads();
    if (threadIdx.x == 0) {
        unsigned* bar = b.bar;
        __builtin_amdgcn_s_waitcnt(0);
        unsigned nloc = b.st[0], nx = b.st[1];
        if (nloc == 0u) { xcd_barrier_complete(bar, b.x, nloc, nx); b.st[0] = nloc; b.st[1] = nx; }
        const unsigned old = xb_add(&bar[XB_XSUB(b.x)], 1u);
        const unsigned gen = old / nloc;
        if (old + 1u == (gen + 1u) * nloc) {
            __builtin_amdgcn_fence(__ATOMIC_RELEASE, "agent");
            asm volatile("s_waitcnt vmcnt(0)" ::: "memory");
            const unsigned og = xb_add(&bar[XB_TOP], 1u);
            const unsigned tg = og / nx;
            if (og + 1u == (tg + 1u) * nx) xb_add(&bar[XB_TOPGEN], 1u);
            else XB_SPIN(xb_ld(&bar[XB_TOPGEN]) == tg, bar);
            __builtin_amdgcn_fence(__ATOMIC_ACQUIRE, "agent");
            xb_add(&bar[XB_XGEN(b.x)], 1u);
            asm volatile("s_waitcnt vmcnt(0)" ::: "memory");
        } else {
            XB_SPIN(xb_ld(&bar[XB_XGEN(b.x)]) == gen, bar);
            __builtin_amdgcn_fence(__ATOMIC_ACQUIRE, "agent");
            asm volatile("s_waitcnt vmcnt(0)" ::: "memory");
        }
    }
    __syncthreads();
}

struct Args { const float* in[17]; float* out; unsigned char* ws; };
typedef const __attribute__((address_space(4))) Args* KArgs;
struct Frame {
    LAS unsigned char* lds;
    volatile LAS unsigned* MISC;
    int tid, lane, wave;
    int vcu, G;
    KArgs ka;
    __device__ __forceinline__ void phase() { KArgs p = (KArgs)__builtin_amdgcn_kernarg_segment_ptr(); asm volatile("" : "+s"(p)); ka = p; int t = threadIdx.x; asm volatile("" : "+v"(t)); tid = t; lane = t & 63; wave = __builtin_amdgcn_readfirstlane(t >> 6); }
    __device__ __forceinline__ const float* in(int i) const { return ka->in[i]; }
    __device__ __forceinline__ float* out() const { return ka->out; }
    __device__ __forceinline__ unsigned char* ws() const { return ka->ws; }
    __device__ __forceinline__ const float* x() const { return in(0); }
    __device__ __forceinline__ const float* c() const { return in(1); }
    __device__ __forceinline__ const float* w_ada() const { return in(2); }
    __device__ __forceinline__ const float* b_ada() const { return in(3); }
    __device__ __forceinline__ const float* w1i() const { return in(4); }
    __device__ __forceinline__ const float* w1o() const { return in(5); }
    __device__ __forceinline__ const float* wmi() const { return in(6); }
    __device__ __forceinline__ const float* b_fox_f() const { return in(7); }
    __device__ __forceinline__ const float* b_m_i() const { return in(8); }
    __device__ __forceinline__ const float* b_m_f() const { return in(9); }
    __device__ __forceinline__ const float* w_conv() const { return in(10); }
    __device__ __forceinline__ const float* b_conv() const { return in(11); }
    __device__ __forceinline__ const float* g_mhn() const { return in(12); }
    __device__ __forceinline__ const float* wmo() const { return in(13); }
    __device__ __forceinline__ const float* w2i() const { return in(14); }
    __device__ __forceinline__ const float* w2o() const { return in(15); }
    __device__ __forceinline__ const float* g_final() const { return in(16); }
    __device__ __forceinline__ gu32* ctl() const { return (gu32*)(ws() + WS_CTL); }
    __device__ __forceinline__ bf16* W1I_t() const { return (bf16*)(ws() + WS_W1I); }
    __device__ __forceinline__ bf16* W1O_t() const { return (bf16*)(ws() + WS_W1O); }
    __device__ __forceinline__ bf16* WMI_t() const { return (bf16*)(ws() + WS_WMI); }
    __device__ __forceinline__ bf16* WMO_t() const { return (bf16*)(ws() + WS_WMO); }
    __device__ __forceinline__ bf16* W2I_t() const { return (bf16*)(ws() + WS_W2I); }
    __device__ __forceinline__ bf16* W2O_t() const { return (bf16*)(ws() + WS_W2O); }
    __device__ __forceinline__ bf16* XN() const { return (bf16*)(ws() + WS_XN); }
    __device__ __forceinline__ bf16* Y() const { return (bf16*)(ws() + WS_Y); }
    __device__ __forceinline__ bf16* ACT() const { return (bf16*)(ws() + WS_ACT); }
    __device__ __forceinline__ bf16* MIXB() const { return (bf16*)(ws() + WS_ACT); }
    __device__ __forceinline__ float* MOD() const { return (float*)(ws() + WS_MOD); }
    __device__ __forceinline__ float* GATES() const { return (float*)(ws() + WS_GATES); }
    __device__ __forceinline__ float* HB() const { return (float*)(ws() + WS_XN); }
    __device__ __forceinline__ bf16* QC() const { return (bf16*)(ws() + WS_QC); }
    __device__ __forceinline__ bf16* KC() const { return (bf16*)(ws() + WS_KC); }
    __device__ __forceinline__ float* MS() const { return (float*)(ws() + WS_MS); }
    __device__ __forceinline__ float* DEC() const { return (float*)(ws() + WS_DEC); }
    __device__ __forceinline__ float* CB() const { return (float*)(ws() + WS_CB); }
    __device__ __forceinline__ float* CT() const { return (float*)(ws() + WS_CT); }
};

__device__ __forceinline__ float wave_sum(float v) {
#pragma unroll
    for (int o = 1; o < 64; o <<= 1) v += __shfl_xor(v, o);
    return v;
}
__device__ __forceinline__ float silu_d(float g) { return g / (1.0f + __expf(-g)); }
__device__ __forceinline__ float logsigmoid_d(float x) { return fminf(x, 0.0f) - log1pf(__expf(-fabsf(x))); }
__device__ __forceinline__ float bf2f(bf16 v) { return __uint_as_float((unsigned)v << 16); }

struct TrItem { const float* W; bf16* WT; int N, Kd, k0, nsrc0, drow0; };
__device__ __forceinline__ void tr_load(const TrItem& t, f32x4 (&v)[8], int lane) {
    const int kr = lane >> 3, n4 = (lane & 7) * 4;
#pragma unroll
    for (int i = 0; i < 8; ++i) v[i] = __builtin_nontemporal_load((const GAS f32x4*)(t.W + (size_t)(t.k0 + kr + 8 * i) * t.N + t.nsrc0 + n4));
}
__device__ __forceinline__ void tr_finish(const TrItem& t, const f32x4 (&v)[8], LAS float* scr, int lane) {
    { const int kr = lane >> 3, n4 = (lane & 7) * 4;
#pragma unroll
      for (int i = 0; i < 8; ++i) { LAS float* p = scr + (kr + 8 * i) * 33 + n4; p[0] = v[i].x; p[1] = v[i].y; p[2] = v[i].z; p[3] = v[i].w; } }
    LDS_WAIT(); asm volatile("" ::: "memory");
    const int c = lane & 7;
#pragma unroll
    for (int j = 0; j < 4; ++j) { const int n = (lane >> 3) + 8 * j; const LAS float* s = scr + (8 * c) * 33 + n;
        v4u o; o.x = pk2(s[0 * 33], s[1 * 33]); o.y = pk2(s[2 * 33], s[3 * 33]); o.z = pk2(s[4 * 33], s[5 * 33]); o.w = pk2(s[6 * 33], s[7 * 33]);
        *(GAS v4u*)(t.WT + (size_t)(t.drow0 + n) * t.Kd + t.k0 + 8 * c) = o; }
    LDS_WAIT(); asm volatile("" ::: "memory");
}
__device__ __forceinline__ void gate_tile_item(const float* W, bf16* WT, int kb, int lane) {
    const int k = kb * 64 + lane;
    const GAS f32x4* p0 = (const GAS f32x4*)(W + (size_t)k * MIXN + 1536); const GAS f32x4* p1 = (const GAS f32x4*)(W + (size_t)k * MIXN + 3592);
    const f32x4 a0 = p0[0], a1 = p0[1], b0 = p1[0], b1 = p1[1];
    const float v[16] = {a0.x, a0.y, a0.z, a0.w, a1.x, a1.y, a1.z, a1.w, b0.x, b0.y, b0.z, b0.w, b1.x, b1.y, b1.z, b1.w};
#pragma unroll
    for (int r = 0; r < 16; ++r) WT[(size_t)(3584 + r) * D + k] = (bf16)f2bf(v[r]);
    const v4u z = (v4u){0u, 0u, 0u, 0u};
#pragma unroll 1
    for (int r = 0; r < 15; ++r) { GAS v4u* zp = (GAS v4u*)(WT + (size_t)(3584 + 16 + 15 * kb + r) * D) + lane; zp[0] = z; zp[64] = z; }
}
__device__ __forceinline__ void ada_item(const Frame& F, int a, const LAS float* cact) {
    const int cl = F.lane & 7, kp = F.lane >> 3, col = 32 * a + 4 * cl;
    f32x4 acc[4];
#pragma unroll
    for (int b = 0; b < 4; ++b) acc[b] = (f32x4){0.f, 0.f, 0.f, 0.f};
    const float* wp = F.w_ada() + (size_t)kp * NMOD + col;
#pragma unroll 1
    for (int k0 = 0; k0 < D; k0 += 128) {
        f32x4 w[16];
#pragma unroll
        for (int i = 0; i < 16; ++i) w[i] = *(const GAS f32x4*)(wp + (size_t)(k0 + 8 * i) * NMOD);
#pragma unroll
        for (int i = 0; i < 16; ++i) { const int k = k0 + 8 * i + kp;
#pragma unroll
            for (int b = 0; b < 4; ++b) acc[b] += w[i] * cact[b * D + k]; }
    }
#pragma unroll
    for (int b = 0; b < 4; ++b)
#pragma unroll
        for (int j = 0; j < 4; ++j) { float v = acc[b][j]; v += __shfl_xor(v, 8); v += __shfl_xor(v, 16); v += __shfl_xor(v, 32); acc[b][j] = v; }
    if (kp == 0) { const f32x4 bb = *(const GAS f32x4*)(F.b_ada() + col);
#pragma unroll
        for (int b = 0; b < 4; ++b) *(GAS f32x4*)(F.MOD() + (size_t)b * NMOD + col) = acc[b] + bb; }
}

template <int SUB> __device__ __forceinline__ void p0_prologue(Frame& F) {
    LAS float* scr = (LAS float*)(F.lds + F.wave * 8704);
    LAS float* cact = (LAS float*)(F.lds + 8 * 8704);
    for (int i = F.tid; i < BATCH * D; i += NWAVES * 64) cact[i] = silu_d(F.c()[i]);
    __syncthreads();
    if (!(SUB & 1)) {
    if (F.wave == 0) { for (int a = F.vcu; a < NMOD / 32; a += 8 * F.G) ada_item(F, a, cact); }
    if (F.wave == 1) { for (int a = F.G + F.vcu; a < NMOD / 32; a += 8 * F.G) ada_item(F, a, cact); }
    }
    const int gw = F.vcu * NWAVES + F.wave, NGW = F.G * NWAVES;
    constexpr int I_FI = (D / 64) * (2 * FF / 32), I_FO = (FF / 64) * (D / 32), I_MI = (D / 64) * (3584 / 32), I_MO = (D / 64) * (D / 32), I_G = D / 64;
    constexpr int NTR = 2 * I_FI + 2 * I_FO + I_MI + I_MO;
    auto decode = [&](int r, TrItem& t) {
        if (r < 2 * I_FI) {
            t.W = (r < I_FI) ? F.w1i() : F.w2i(); t.WT = (r < I_FI) ? F.W1I_t() : F.W2I_t(); if (r >= I_FI) r -= I_FI;
            const int nrb = 2 * FF / 32, kb = r / nrb, rb = r % nrb, drow = rb * 32, tile = drow >> 8, within = drow & 255, half = within >> 7, hid = tile * 128 + (within & 127);
            t.N = 2 * FF; t.Kd = D; t.k0 = kb * 64; t.nsrc0 = half * FF + hid; t.drow0 = drow; return; }
        r -= 2 * I_FI;
        if (r < 2 * I_FO) {
            t.W = (r < I_FO) ? F.w1o() : F.w2o(); t.WT = (r < I_FO) ? F.W1O_t() : F.W2O_t(); if (r >= I_FO) r -= I_FO;
            const int nrb = D / 32, kb = r / nrb, rb = r % nrb;
            t.N = D; t.Kd = FF; t.k0 = kb * 64; t.nsrc0 = rb * 32; t.drow0 = rb * 32; return; }
        r -= 2 * I_FO;
        if (r < I_MI) {
            const int nrb = 3584 / 32, kb = r / nrb, rb = r % nrb, drow = rb * 32, tt = drow >> 9, src = (tt < 3 ? 512 * tt : 512 * tt + 8) + (drow & 511);
            t.W = F.wmi(); t.WT = F.WMI_t(); t.N = MIXN; t.Kd = D; t.k0 = kb * 64; t.nsrc0 = src; t.drow0 = drow; return; }
        r -= I_MI;
        { const int nrb = D / 32, kb = r / nrb, rb = r % nrb; t.W = F.wmo(); t.WT = F.WMO_t(); t.N = D; t.Kd = D; t.k0 = kb * 64; t.nsrc0 = rb * 32; t.drow0 = rb * 32; }
    };
    if (!(SUB & 2)) {
#pragma unroll 1
    for (int it = gw; it < NTR; it += 2 * NGW) {
        TrItem ta, tb; f32x4 va[8], vb[8]; const bool two = it + NGW < NTR;
        decode(it, ta); tr_load(ta, va, F.lane);
        if (two) { decode(it + NGW, tb); tr_load(tb, vb, F.lane); }
        tr_finish(ta, va, scr, F.lane);
        if (two) tr_finish(tb, vb, scr, F.lane);
    } }
    if (!(SUB & 4)) { for (int it = gw; it < I_G; it += NGW) gate_tile_item(F.wmi(), F.WMI_t(), it, F.lane); }
}

__device__ __forceinline__ void norm_mod_rows(Frame& F, const float* src, bf16* dst, int shift_off, int scale_off) {
    constexpr int RR = 4;
    const int gw = F.vcu * NWAVES + F.wave, NGW = F.G * NWAVES;
#pragma unroll 1
    for (int m0 = gw * RR; m0 < M; m0 += NGW * RR) {
        const float* mb = F.MOD() + (size_t)(m0 / SEQ) * NMOD;
        f32x4 v[RR][4]; float s[RR];
#pragma unroll
        for (int r = 0; r < RR; ++r) { const GAS f32x4* xr = (const GAS f32x4*)(src + (size_t)(m0 + r) * D) + F.lane;
#pragma unroll
            for (int j = 0; j < 4; ++j) v[r][j] = xr[64 * j]; }
        f32x4 sh[4], sc[4];
#pragma unroll
        for (int j = 0; j < 4; ++j) { sh[j] = *((const GAS f32x4*)(mb + shift_off) + F.lane + 64 * j); sc[j] = *((const GAS f32x4*)(mb + scale_off) + F.lane + 64 * j) + 1.0f; }
#pragma unroll
        for (int r = 0; r < RR; ++r) { float a = 0.f;
#pragma unroll
            for (int j = 0; j < 4; ++j) a += (v[r][j].x * v[r][j].x + v[r][j].y * v[r][j].y) + (v[r][j].z * v[r][j].z + v[r][j].w * v[r][j].w);
            s[r] = a; }
#pragma unroll
        for (int o = 1; o < 64; o <<= 1) {
#pragma unroll
            for (int r = 0; r < RR; ++r) s[r] += __shfl_xor(s[r], o); }
#pragma unroll
        for (int r = 0; r < RR; ++r) { const float rstd = 1.f / sqrtf(s[r] * (1.f / D) + EPS);
            GAS unsigned long long* o8 = (GAS unsigned long long*)(dst + (size_t)(m0 + r) * D) + F.lane;
#pragma unroll
            for (int j = 0; j < 4; ++j) { const f32x4 h = v[r][j] * rstd * sc[j] + sh[j]; o8[64 * j] = (unsigned long long)pk2(h.x, h.y) | ((unsigned long long)pk2(h.z, h.w) << 32); } }
    }
}
__device__ __forceinline__ void final_norm_rows(Frame& F, float* xio) {
    constexpr int RR = 4;
    const int gw = F.vcu * NWAVES + F.wave, NGW = F.G * NWAVES;
    f32x4 g[4];
#pragma unroll
    for (int j = 0; j < 4; ++j) g[j] = *((const GAS f32x4*)F.g_final() + F.lane + 64 * j);
#pragma unroll 1
    for (int m0 = gw * RR; m0 < M; m0 += NGW * RR) {
        f32x4 v[RR][4]; float s[RR];
#pragma unroll
        for (int r = 0; r < RR; ++r) { const GAS f32x4* xr = (const GAS f32x4*)(xio + (size_t)(m0 + r) * D) + F.lane;
#pragma unroll
            for (int j = 0; j < 4; ++j) v[r][j] = xr[64 * j]; }
#pragma unroll
        for (int r = 0; r < RR; ++r) { float a = 0.f;
#pragma unroll
            for (int j = 0; j < 4; ++j) a += (v[r][j].x * v[r][j].x + v[r][j].y * v[r][j].y) + (v[r][j].z * v[r][j].z + v[r][j].w * v[r][j].w);
            s[r] = a; }
#pragma unroll
        for (int o = 1; o < 64; o <<= 1) {
#pragma unroll
            for (int r = 0; r < RR; ++r) s[r] += __shfl_xor(s[r], o); }
#pragma unroll
        for (int r = 0; r < RR; ++r) { const float rstd = 1.f / sqrtf(s[r] * (1.f / D) + EPS);
            GAS f32x4* xr = (GAS f32x4*)(xio + (size_t)(m0 + r) * D) + F.lane;
#pragma unroll
            for (int j = 0; j < 4; ++j) xr[64 * j] = v[r][j] * rstd * g[j]; }
    }
}
__device__ __forceinline__ void mlstm_fixup_rows(Frame& F) {
    constexpr int RR = 4;
    const int gw = F.vcu * NWAVES + F.wave, NGW = F.G * NWAVES;
    const bf16* MO = F.MIXB() + (size_t)5 * M * 512;
    const GAS f32x4* gp = (const GAS f32x4*)(F.g_mhn() + 8 * F.lane); const f32x4 g0 = gp[0], g1 = gp[1];
    const float gg[8] = {g0.x, g0.y, g0.z, g0.w, g1.x, g1.y, g1.z, g1.w};
#pragma unroll 1
    for (int m0 = gw * RR; m0 < M; m0 += NGW * RR) {
        f32x4 h0[RR], h1[RR]; v4u mo[RR]; float s[RR];
#pragma unroll
        for (int r = 0; r < RR; ++r) { const GAS f32x4* hp = (const GAS f32x4*)(F.HB() + (size_t)(m0 + r) * 512 + 8 * F.lane); h0[r] = hp[0]; h1[r] = hp[1];
            mo[r] = *(const GAS v4u*)(MO + (size_t)(m0 + r) * 512 + 8 * F.lane); }
#pragma unroll
        for (int r = 0; r < RR; ++r) s[r] = (h0[r].x * h0[r].x + h0[r].y * h0[r].y) + (h0[r].z * h0[r].z + h0[r].w * h0[r].w) + (h1[r].x * h1[r].x + h1[r].y * h1[r].y) + (h1[r].z * h1[r].z + h1[r].w * h1[r].w);
#pragma unroll
        for (int o = 1; o < 16; o <<= 1) {
#pragma unroll
            for (int r = 0; r < RR; ++r) s[r] += __shfl_xor(s[r], o); }
#pragma unroll
        for (int r = 0; r < RR; ++r) { const float rstd = 1.f / sqrtf(s[r] * (1.f / 128.f) + EPS);
            const float hh[8] = {h0[r].x, h0[r].y, h0[r].z, h0[r].w, h1[r].x, h1[r].y, h1[r].z, h1[r].w}; const unsigned mw[4] = {mo[r].x, mo[r].y, mo[r].z, mo[r].w}; float o[8];
#pragma unroll
            for (int j = 0; j < 8; ++j) { const float mov = __uint_as_float((j & 1) ? (mw[j >> 1] & 0xffff0000u) : (mw[j >> 1] << 16)); o[j] = (1.0f / (1.0f + __expf(-mov))) * (hh[j] * rstd * gg[j]); }
            *(GAS v4u*)(F.Y() + (size_t)(m0 + r) * D + 512 + 8 * F.lane) = (v4u){pk2(o[0], o[1]), pk2(o[2], o[3]), pk2(o[4], o[5]), pk2(o[6], o[7])}; }
    }
}

__device__ __forceinline__ void fox_cumsum(Frame& F, int b, int h, int n, LAS float* cb, LAS float* scratch) {
    const float bias = F.b_fox_f()[h];
    const int i0 = F.tid * 8;
    float v[8]; float run = 0.f;
#pragma unroll
    for (int j = 0; j < 8; ++j) { float lf = 0.f; if (i0 + j < n) lf = logsigmoid_d(F.GATES()[(size_t)(b * SEQ + i0 + j) * 16 + h] + bias); run += lf; v[j] = run; }
    float tot = run;
#pragma unroll
    for (int o = 1; o < 64; o <<= 1) { const float t = __shfl_up(tot, o); if (F.lane >= o) tot += t; }
    if (F.lane == 63) scratch[F.wave] = tot;
    __syncthreads();
    float woff = 0.f;
#pragma unroll
    for (int w = 0; w < 8; ++w) { const float s = scratch[w]; if (w < F.wave) woff += s; }
    const float base = woff + tot - run;
#pragma unroll
    for (int j = 0; j < 8; ++j) if (i0 + j < n) cb[i0 + j] = (base + v[j]) * 1.4426950408889634f;
    __syncthreads();
}

__device__ __forceinline__ void attn_naive_unit(Frame& F, int b, int h, int qb) {
    LAS float* cb = (LAS float*)F.lds;
    LAS float* Ks = cb + 4096;
    LAS float* Vs = Ks + 4096;
    LAS float* scr = Vs + 4096;
    const bf16* FK = F.MIXB(); const bf16* FV = F.MIXB() + (size_t)M * 512;
    fox_cumsum(F, b, h, (qb + 1) * 256, cb, scr);
    const int r = F.tid & 255, dh = F.tid >> 8, t = qb * 256 + r; const size_t grow = (size_t)b * SEQ + t;
    unsigned qp[32]; float o[32];
    { const v4u* qptr = (const v4u*)(F.Y() + grow * D + h * 64);
#pragma unroll
      for (int c = 0; c < 8; ++c) { const v4u w = qptr[c]; qp[4 * c] = w.x; qp[4 * c + 1] = w.y; qp[4 * c + 2] = w.z; qp[4 * c + 3] = w.w; } }
#pragma unroll
    for (int d = 0; d < 32; ++d) o[d] = 0.f;
    float mrun = -1e30f, l = 0.f;
    const int NT = 4 * (qb + 1);
#pragma unroll 1
    for (int kt = 0; kt < NT; ++kt) {
        __syncthreads();
        { const int s = F.tid >> 3, d0 = (F.tid & 7) * 8; const size_t krow = (size_t)b * SEQ + kt * 64 + s;
          const v4u kw = *(const v4u*)(FK + krow * 512 + h * 64 + d0), vw = *(const v4u*)(FV + krow * 512 + h * 64 + d0);
          const unsigned kk[4] = {kw.x, kw.y, kw.z, kw.w}, vv[4] = {vw.x, vw.y, vw.z, vw.w};
#pragma unroll
          for (int j = 0; j < 4; ++j) { Ks[s * 64 + d0 + 2 * j] = __uint_as_float(kk[j] << 16); Ks[s * 64 + d0 + 2 * j + 1] = __uint_as_float(kk[j] & 0xffff0000u);
                                        Vs[s * 64 + d0 + 2 * j] = __uint_as_float(vv[j] << 16); Vs[s * 64 + d0 + 2 * j + 1] = __uint_as_float(vv[j] & 0xffff0000u); } }
        __syncthreads();
#pragma unroll 1
        for (int s = 0; s < 64; ++s) {
            const int kp = kt * 64 + s;
            if (kp <= t) {
                float dot = 0.f;
#pragma unroll
                for (int d = 0; d < 64; d += 4) { const f32x4 kv = *(const LAS f32x4*)(Ks + s * 64 + d);
                    dot += __uint_as_float(qp[d >> 1] << 16) * kv.x + __uint_as_float(qp[d >> 1] & 0xffff0000u) * kv.y + __uint_as_float(qp[(d >> 1) + 1] << 16) * kv.z + __uint_as_float(qp[(d >> 1) + 1] & 0xffff0000u) * kv.w; }
                const float sc = dot - cb[kp];
                if (sc > mrun) { const float f = exp2f(mrun - sc); l *= f;
#pragma unroll
                    for (int d = 0; d < 32; ++d) o[d] *= f;
                    mrun = sc; }
                const float p = exp2f(sc - mrun); l += p;
#pragma unroll
                for (int d = 0; d < 32; d += 4) { const f32x4 vv = *(const LAS f32x4*)(Vs + s * 64 + dh * 32 + d); o[d] += p * vv.x; o[d + 1] += p * vv.y; o[d + 2] += p * vv.z; o[d + 3] += p * vv.w; }
            }
        }
    }
    __syncthreads();
    { const float inv = 1.0f / l;
      v4u* op = (v4u*)(F.Y() + grow * D + h * 64 + dh * 32);
#pragma unroll
      for (int c = 0; c < 4; ++c) op[c] = (v4u){pk2(o[8 * c] * inv, o[8 * c + 1] * inv), pk2(o[8 * c + 2] * inv, o[8 * c + 3] * inv), pk2(o[8 * c + 4] * inv, o[8 * c + 5] * inv), pk2(o[8 * c + 6] * inv, o[8 * c + 7] * inv)}; }
    __syncthreads();
}

__device__ __forceinline__ void attn_fast_unit(Frame& F, int b, int h, int qb) {
    LAS float* cb = (LAS float*)(F.lds + 86016);
    { LAS float* off = cb + 4096;
      if (F.wave == 0) { const float tot = F.CT()[(b * 8 + h) * 64 + F.lane]; float a = tot;
#pragma unroll
          for (int o = 1; o < 64; o <<= 1) { const float v = __shfl_up(a, o); if (F.lane >= o) a += v; }
          off[F.lane] = a - tot; }
      __syncthreads();
      const float* cbg = F.CB() + (size_t)(b * 8 + h) * SEQ; const int i0 = F.tid * 8;
      if (i0 < (qb + 1) * 256) { const float o_ = off[i0 >> 6]; *(LAS f32x4*)(cb + i0) = *(const GAS f32x4*)(cbg + i0) + o_; *(LAS f32x4*)(cb + i0 + 4) = *(const GAS f32x4*)(cbg + i0 + 4) + o_; }
      __syncthreads(); }
    const attn_body::bf16* FK = (const attn_body::bf16*)F.MIXB(); const attn_body::bf16* FV = FK + (size_t)M * 512;
    attn_body::attn_unit<8>(b, h, qb, (const attn_body::bf16*)F.Y(), FK, FV, (attn_body::bf16*)F.Y(), (char*)F.lds, (attn_body::lds_fptr)cb);
}

__device__ __forceinline__ void mlstm_naive_unit(Frame& F, int b, int h, int db) {
    LAS float* L = (LAS float*)F.lds;
    LAS float* qs = L;
    LAS float* ks = qs + 64 * 129;
    LAS float* vs = ks + 64 * 129;
    LAS float* Cs = vs + 64 * 33;
    LAS float* ns = Cs + 32 * 129;
    LAS float* Sm = ns + 128;
    LAS float* av = Sm + 64 * 65;
    LAS float* icv = av + 64;
    LAS float* mtv = icv + 64;
    LAS float* iwv = mtv + 64;
    LAS float* wtv = iwv + 64;
    LAS float* denv = wtv + 64;
    LAS float* scl = denv + 64;
    const bf16* MQ = F.MIXB() + (size_t)2 * M * 512; const bf16* MK = F.MIXB() + (size_t)3 * M * 512; const bf16* MV = F.MIXB() + (size_t)4 * M * 512;
    for (int i = F.tid; i < 32 * 129; i += 512) Cs[i] = 0.f;
    if (F.tid < 128) ns[F.tid] = 0.f;
    float mstate = 0.f;
    const float bi = F.b_m_i()[h], bfg = F.b_m_f()[h];
    __syncthreads();
#pragma unroll 1
    for (int j = 0; j < SEQ / 64; ++j) {
        const int t0 = 64 * j; const size_t grow0 = (size_t)b * SEQ + t0;
#pragma unroll 1
        for (int n = 0; n < 16; ++n) { const int idx = F.tid + 512 * n, t = idx >> 7, c = idx & 127, ch = h * 128 + c;
            float aq = F.b_conv()[ch], ak = F.b_conv()[512 + ch];
#pragma unroll
            for (int w = 0; w < 4; ++w) { const int tt = t0 + t - 3 + w; if (tt >= 0) { const size_t ro = ((size_t)b * SEQ + tt) * 512 + ch; aq += F.w_conv()[w * 1024 + ch] * bf2f(MQ[ro]); ak += F.w_conv()[w * 1024 + 512 + ch] * bf2f(MK[ro]); } }
            qs[t * 129 + c] = silu_d(aq); ks[t * 129 + c] = silu_d(ak) * 0.08838834764831845f; }
#pragma unroll 1
        for (int n = 0; n < 4; ++n) { const int idx = F.tid + 512 * n, t = idx >> 5, d = idx & 31; vs[t * 33 + d] = bf2f(MV[(grow0 + t) * 512 + h * 128 + db * 32 + d]); }
        if (F.wave == 0) { const int l = F.lane;
            const float ic = F.GATES()[(grow0 + l) * 16 + 8 + h] + bi; const float lf = logsigmoid_d(F.GATES()[(grow0 + l) * 16 + 12 + h] + bfg);
            float a = lf;
#pragma unroll
            for (int o = 1; o < 64; o <<= 1) { const float t = __shfl_up(a, o); if (l >= o) a += t; }
            const float g = __shfl(a, 63);
            float pm = ic - a;
#pragma unroll
            for (int o = 1; o < 64; o <<= 1) { const float t = __shfl_up(pm, o); if (l >= o) pm = fmaxf(pm, t); }
            const float mt = fmaxf(a + mstate, a + pm);
            const float wend = g - a + ic; float mw = wend;
#pragma unroll
            for (int o = 1; o < 64; o <<= 1) mw = fmaxf(mw, __shfl_xor(mw, o));
            const float mnew = fmaxf(g + mstate, mw);
            av[l] = a; icv[l] = ic; mtv[l] = mt; iwv[l] = __expf(a + mstate - mt); wtv[l] = __expf(wend - mnew);
            if (l == 0) scl[0] = __expf(g + mstate - mnew);
            mstate = mnew; }
        __syncthreads();
        { const int t = F.tid >> 3;
#pragma unroll 1
          for (int jj = 0; jj < 8; ++jj) { const int s = (F.tid & 7) + 8 * jj; float dot = 0.f;
#pragma unroll 4
              for (int e = 0; e < 128; ++e) dot += qs[t * 129 + e] * ks[s * 129 + e];
              Sm[t * 65 + s] = (s <= t) ? dot * __expf(av[t] - av[s] + icv[s] - mtv[t]) : 0.f; } }
        __syncthreads();
        if (F.tid < 64) { const int t = F.tid; float ds = 0.f, dn = 0.f;
            for (int s = 0; s < 64; ++s) ds += Sm[t * 65 + s];
            for (int e = 0; e < 128; ++e) dn += ns[e] * qs[t * 129 + e];
            denv[t] = ds + iwv[t] * dn; }
        __syncthreads();
#pragma unroll 1
        for (int n = 0; n < 4; ++n) { const int idx = F.tid + 512 * n, t = idx >> 5, d = idx & 31; float intra = 0.f, inter = 0.f;
#pragma unroll 4
            for (int s = 0; s < 64; ++s) intra += Sm[t * 65 + s] * vs[s * 33 + d];
#pragma unroll 4
            for (int e = 0; e < 128; ++e) inter += Cs[d * 129 + e] * qs[t * 129 + e];
            const float num = intra + iwv[t] * inter; const float den = fmaxf(fabsf(denv[t]), __expf(-mtv[t]));
            F.HB()[(grow0 + t) * 512 + h * 128 + db * 32 + d] = num / den; }
        __syncthreads();
        { const float decay = scl[0];
#pragma unroll 1
          for (int n = 0; n < 8; ++n) { const int idx = F.tid + 512 * n, d = idx >> 7, e = idx & 127; float acc = 0.f;
#pragma unroll 4
              for (int l = 0; l < 64; ++l) acc += wtv[l] * vs[l * 33 + d] * ks[l * 129 + e];
              Cs[d * 129 + e] = decay * Cs[d * 129 + e] + acc; }
          if (F.tid < 128) { const int e = F.tid; float acc = 0.f; for (int l = 0; l < 64; ++l) acc += wtv[l] * ks[l * 129 + e]; ns[e] = decay * ns[e] + acc; } }
        __syncthreads();
    }
}

__device__ __forceinline__ void mlstm_chunk_item(Frame& F, int item) {
    const int series = item >> 6, j = item & 63, b = series >> 2, h = series & 3, l = F.lane;
    const float bi = F.b_m_i()[h], bfg = F.b_m_f()[h];
    const float* G = F.GATES(); float* MS = F.MS() + (size_t)series * 4 * SEQ;
    const int t = 64 * j + l; const size_t grow = (size_t)b * SEQ + t;
    const float ic = G[grow * 16 + 8 + h] + bi; float a = logsigmoid_d(G[grow * 16 + 12 + h] + bfg);
#pragma unroll
    for (int o = 1; o < 64; o <<= 1) { const float v = __shfl_up(a, o); if (l >= o) a += v; }
    const float g = __shfl(a, 63);
    float pm = ic - a;
#pragma unroll
    for (int o = 1; o < 64; o <<= 1) { const float v = __shfl_up(pm, o); if (l >= o) pm = fmaxf(pm, v); }
    const float wend = g - a + ic; float mw = wend;
#pragma unroll
    for (int o = 1; o < 64; o <<= 1) mw = fmaxf(mw, __shfl_xor(mw, o));
    MS[0 * SEQ + t] = a; MS[1 * SEQ + t] = (ic - a) * 1.4426950408889634f; MS[2 * SEQ + t] = pm; MS[3 * SEQ + t] = wend;
    if (l == 0) { float* cg = F.DEC() + (series * 64 + j) * 2; cg[0] = g; cg[1] = mw; }
}
__device__ __forceinline__ void fox_chunk_item(Frame& F, int item) {
    const int series = item >> 6, j = item & 63, b = series >> 3, h = series & 7, l = F.lane; const float bias = F.b_fox_f()[h];
    const int t = 64 * j + l;
    float a = logsigmoid_d(F.GATES()[((size_t)b * SEQ + t) * 16 + h] + bias);
#pragma unroll
    for (int o = 1; o < 64; o <<= 1) { const float v = __shfl_up(a, o); if (l >= o) a += v; }
    F.CB()[(size_t)series * SEQ + t] = a * 1.4426950408889634f;
    if (l == 63) F.CT()[series * 64 + j] = a * 1.4426950408889634f;
}
__device__ __forceinline__ void conv_item(Frame& F, int item) {
    const int half = item & 1, m0 = (item >> 1) * 4, t0 = m0 % SEQ, ch = 8 * F.lane;
    const bf16* SRC = F.MIXB() + (size_t)(2 + half) * M * 512; bf16* DST = half ? F.KC() : F.QC();
    const float* wc = F.w_conv() + half * 512 + ch; const float* bc = F.b_conv() + half * 512 + ch;
    float w[4][8], bb[8];
#pragma unroll
    for (int k = 0; k < 4; ++k) { const f32x4 w0 = *(const GAS f32x4*)(wc + k * 1024), w1 = *(const GAS f32x4*)(wc + k * 1024 + 4); w[k][0] = w0.x; w[k][1] = w0.y; w[k][2] = w0.z; w[k][3] = w0.w; w[k][4] = w1.x; w[k][5] = w1.y; w[k][6] = w1.z; w[k][7] = w1.w; }
    { const f32x4 b0 = *(const GAS f32x4*)bc, b1 = *(const GAS f32x4*)(bc + 4); bb[0] = b0.x; bb[1] = b0.y; bb[2] = b0.z; bb[3] = b0.w; bb[4] = b1.x; bb[5] = b1.y; bb[6] = b1.z; bb[7] = b1.w; }
    v4u raw[7];
#pragma unroll
    for (int r = 0; r < 7; ++r) { raw[r] = (v4u){0u, 0u, 0u, 0u}; if (t0 + r - 3 >= 0) raw[r] = *(const GAS v4u*)(SRC + (size_t)(m0 + r - 3) * 512 + ch); }
    const float osc = half ? 0.08838834764831845f : 1.0f;
#pragma unroll
    for (int r = 0; r < 4; ++r) {
        float acc[8];
#pragma unroll
        for (int c = 0; c < 8; ++c) acc[c] = bb[c];
#pragma unroll
        for (int k = 0; k < 4; ++k) { const v4u rw = raw[r + k]; const unsigned ww[4] = {rw.x, rw.y, rw.z, rw.w};
#pragma unroll
            for (int c = 0; c < 8; ++c) { const float xv = __uint_as_float((c & 1) ? (ww[c >> 1] & 0xffff0000u) : (ww[c >> 1] << 16)); acc[c] += w[k][c] * xv; } }
#pragma unroll
        for (int c = 0; c < 8; ++c) acc[c] = silu_d(acc[c]) * osc;
        *(GAS v4u*)(DST + (size_t)(m0 + r) * 512 + ch) = (v4u){pk2(acc[0], acc[1]), pk2(acc[2], acc[3]), pk2(acc[4], acc[5]), pk2(acc[6], acc[7])};
    }
}
__device__ __forceinline__ void mixprep_phase(Frame& F) {
    const int gw = F.vcu * NWAVES + F.wave, NGW = F.G * NWAVES;
#pragma unroll 1
    for (int it = gw; it < 32 * 64; it += NGW) fox_chunk_item(F, it);
#pragma unroll 1
    for (int it = gw; it < 16 * 64; it += NGW) mlstm_chunk_item(F, it);
#pragma unroll 1
    for (int it = gw; it < (M / 4) * 2; it += NGW) conv_item(F, it);
}

namespace ml {
typedef short s16x4 __attribute__((ext_vector_type(4)));
constexpr int PQ = 272, PV = 144;
constexpr int O_QC = 0, O_KC = 64 * PQ, O_VT = 2 * 64 * PQ, O_VW = O_VT + 32 * PV, O_SC = O_VW + 48 * PV, BUF = 47872;
constexpr int O_CB = 2 * BUF, CBB = 48 * PQ, O_DS = O_CB + 2 * CBB, LDS_END = O_DS + 4 * 64;
static_assert(O_SC + 5 * 256 + 16 <= BUF && LDS_END <= 131072, "mLSTM LDS map");
__device__ __forceinline__ f32x4 mfma16(bf16x8 a, bf16x8 b, f32x4 c) { return __builtin_amdgcn_mfma_f32_16x16x32_bf16(a, b, c, 0, 0, 0); }
__device__ __forceinline__ s16x4 trd(const LAS unsigned char* p) { typedef short v4i16_t __attribute__((ext_vector_type(4))); return __builtin_bit_cast(s16x4, __builtin_amdgcn_ds_read_tr16_b64_v4i16((LAS v4i16_t*)p)); }
__device__ __forceinline__ unsigned pkbf(float lo, float hi) { typedef float f32x2_t __attribute__((ext_vector_type(2))); typedef __bf16 bf16x2_t __attribute__((ext_vector_type(2))); f32x2_t v = {lo, hi}; bf16x2_t r = __builtin_convertvector(v, bf16x2_t); return __builtin_bit_cast(unsigned, r); }
}
namespace ml {
struct Stage { v4u rq[2], rk[2]; unsigned long long rv; float a, b2, pm, we, wes, g, mw; };
struct Src { const bf16* QCg; const bf16* KCg; const bf16* Vg; const float* MSg; const float* CGg; };
__device__ __forceinline__ void stage_load(Stage& S, const Src& P, int jn, int tid) {
    const size_t g0 = (size_t)jn * 64;
#pragma unroll
    for (int k = 0; k < 2; ++k) { const int ci = tid + 512 * k, row = ci >> 4, c16 = ci & 15;
        S.rq[k] = *(const GAS v4u*)(P.QCg + (g0 + row) * 512 + c16 * 8); S.rk[k] = *(const GAS v4u*)(P.KCg + (g0 + row) * 512 + c16 * 8); }
    S.rv = *(const GAS unsigned long long*)(P.Vg + (g0 + (tid >> 3)) * 512 + (tid & 7) * 4);
    S.wes = P.MSg[3 * SEQ + g0 + (tid >> 3)]; S.g = P.CGg[2 * jn]; S.mw = P.CGg[2 * jn + 1];
    S.a = 0.f; S.b2 = 0.f; S.pm = 0.f; S.we = 0.f;
    if (tid < 64) { S.a = P.MSg[g0 + tid]; S.b2 = P.MSg[SEQ + g0 + tid]; S.pm = P.MSg[2 * SEQ + g0 + tid]; S.we = P.MSg[3 * SEQ + g0 + tid]; }
}
__device__ __forceinline__ void stage_store(const Stage& S, LAS unsigned char* B, int tid, float& mst) {
    const float mnew = fmaxf(S.g + mst, S.mw); const float rwt = __expf(S.wes - mnew);
#pragma unroll
    for (int k = 0; k < 2; ++k) { const int ci = tid + 512 * k, row = ci >> 4, c16 = ci & 15;
        *(LAS v4u*)(B + O_QC + row * PQ + c16 * 16) = S.rq[k]; *(LAS v4u*)(B + O_KC + row * PQ + c16 * 16) = S.rk[k]; }
    { const int s = tid >> 3, dc = tid & 7;
#pragma unroll
      for (int i = 0; i < 4; ++i) { const unsigned short vb = (unsigned short)(S.rv >> (16 * i)); const float vf = __uint_as_float((unsigned)vb << 16);
          *(LAS unsigned short*)(B + O_VT + (4 * dc + i) * PV + 2 * s) = vb; *(LAS unsigned short*)(B + O_VW + (4 * dc + i) * PV + 2 * s) = (unsigned short)f2bf(vf * rwt); }
      if (dc == 0) *(LAS unsigned short*)(B + O_VW + 32 * PV + 2 * s) = (unsigned short)f2bf(rwt); }
    if (tid < 64) { LAS float* Sc = (LAS float*)(B + O_SC); const float M0 = fmaxf(mst, S.pm), mt = S.a + M0;
        Sc[tid] = -M0 * 1.4426950408889634f; Sc[64 + tid] = S.b2; Sc[128 + tid] = __expf(mst - M0); Sc[192 + tid] = __expf(-mt); Sc[256 + tid] = __expf(S.we - mnew);
        if (tid == 0) Sc[320] = __expf(S.g + mst - mnew); }
    mst = mnew;
}
__device__ __forceinline__ void chunk_step(const LAS unsigned char* Bc, const LAS unsigned char* Cb, LAS unsigned char* Cn, LAS float* dscr, float* op0, f32x4 (&Cacc)[3][2], int w, int l) {
    const int c = l & 15, q = l >> 4;
    const LAS float* SC = (const LAS float*)(Bc + O_SC);
    if (w < 4) {
        bf16x8 qf[4];
#pragma unroll
        for (int ks = 0; ks < 4; ++ks) qf[ks] = *(const LAS bf16x8*)(Bc + O_QC + (16 * w + c) * PQ + (32 * ks + 8 * q) * 2);
        const float A2t = SC[16 * w + c];
        unsigned xs[4][2]; float dsum = 0.f;
#pragma unroll
        for (int si = 0; si < 4; ++si) {
            xs[si][0] = 0u; xs[si][1] = 0u;
            if (si <= w) {
                f32x4 acc = (f32x4){0.f, 0.f, 0.f, 0.f};
#pragma unroll
                for (int ks = 0; ks < 4; ++ks) { const bf16x8 af = *(const LAS bf16x8*)(Bc + O_KC + (16 * si + c) * PQ + (32 * ks + 8 * q) * 2); acc = mfma16(af, qf[ks], acc); }
                const f32x4 b2 = *(const LAS f32x4*)(SC + 64 + 16 * si + 4 * q);
#pragma unroll
                for (int r = 0; r < 4; ++r) { float p = __builtin_amdgcn_exp2f(A2t + b2[r]); if (si == w && 4 * q + r > c) p = 0.f; acc[r] *= p; }
                dsum += (acc[0] + acc[1]) + (acc[2] + acc[3]);
                xs[si][0] = pkbf(acc[0], acc[1]); xs[si][1] = pkbf(acc[2], acc[3]);
            }
        }
        f32x4 z[2] = {(f32x4){0.f, 0.f, 0.f, 0.f}, (f32x4){0.f, 0.f, 0.f, 0.f}};
#pragma unroll
        for (int p = 0; p < 2; ++p) if (2 * p <= w) {
            const bf16x8 af = __builtin_bit_cast(bf16x8, (v4u){xs[2 * p][0], xs[2 * p][1], xs[2 * p + 1][0], xs[2 * p + 1][1]});
#pragma unroll
            for (int dt = 0; dt < 2; ++dt) { const LAS unsigned char* vp = Bc + O_VT + (16 * dt + c) * PV + (32 * p + 4 * q) * 2;
                const unsigned long long lo = *(const LAS unsigned long long*)vp, hi = *(const LAS unsigned long long*)(vp + 32);
                const bf16x8 bfr = __builtin_bit_cast(bf16x8, (v4u){(unsigned)lo, (unsigned)(lo >> 32), (unsigned)hi, (unsigned)(hi >> 32)});
                z[dt] = mfma16(af, bfr, z[dt]); } }
        f32x4 y[3] = {(f32x4){0.f, 0.f, 0.f, 0.f}, (f32x4){0.f, 0.f, 0.f, 0.f}, (f32x4){0.f, 0.f, 0.f, 0.f}};
#pragma unroll
        for (int dt = 0; dt < 3; ++dt)
#pragma unroll
            for (int ks = 0; ks < 4; ++ks) { const bf16x8 bfr = *(const LAS bf16x8*)(Cb + (16 * dt + c) * PQ + (32 * ks + 8 * q) * 2); y[dt] = mfma16(qf[ks], bfr, y[dt]); }
        dsum += __shfl_xor(dsum, 16); dsum += __shfl_xor(dsum, 32);
        if (q == 0) dscr[c] = dsum;
        const f32x4 iw4 = *(const LAS f32x4*)(SC + 128 + 16 * w + 4 * q), em4 = *(const LAS f32x4*)(SC + 192 + 16 * w + 4 * q);
        f32x4 dint;
#pragma unroll
        for (int r = 0; r < 4; ++r) dint[r] = __shfl(y[2][r], l & 48);
        LDS_WAIT();
        const f32x4 dintra = *(const LAS f32x4*)(dscr + 4 * q);
        float* op = op0 + (size_t)(16 * w + 4 * q) * 512 + c;
#pragma unroll
        for (int r = 0; r < 4; ++r) { const float den = fmaxf(fabsf(dintra[r] + iw4[r] * dint[r]), em4[r]); const float inv = 1.0f / den;
            op[(size_t)r * 512] = (z[0][r] + iw4[r] * y[0][r]) * inv; op[(size_t)r * 512 + 16] = (z[1][r] + iw4[r] * y[1][r]) * inv; }
    } else {
        const int v = w - 4; const float decay = SC[320];
#pragma unroll
        for (int i = 0; i < 3; ++i)
#pragma unroll
            for (int k = 0; k < 2; ++k) Cacc[i][k] *= decay;
#pragma unroll
        for (int ks = 0; ks < 2; ++ks) {
            bf16x8 af[3];
#pragma unroll
            for (int dt = 0; dt < 3; ++dt) af[dt] = *(const LAS bf16x8*)(Bc + O_VW + (16 * dt + c) * PV + (32 * ks + 8 * q) * 2);
#pragma unroll
            for (int et = 0; et < 2; ++et) { const LAS unsigned char* kp = Bc + O_KC + (32 * ks + 8 * q + (c >> 2)) * PQ + (32 * v + 16 * et + 4 * (c & 3)) * 2;
                const s16x4 lo = trd(kp), hi = trd(kp + 4 * PQ);
                const bf16x8 bfr = (bf16x8){lo[0], lo[1], lo[2], lo[3], hi[0], hi[1], hi[2], hi[3]};
#pragma unroll
                for (int dt = 0; dt < 3; ++dt) Cacc[dt][et] = mfma16(af[dt], bfr, Cacc[dt][et]); }
        }
#pragma unroll
        for (int et = 0; et < 2; ++et) { LAS unsigned char* cp = Cn + (32 * v + 16 * et + c) * 2;
#pragma unroll
            for (int dt = 0; dt < 2; ++dt)
#pragma unroll
                for (int r = 0; r < 4; ++r) *(LAS unsigned short*)(cp + (16 * dt + 4 * q + r) * PQ) = (unsigned short)f2bf(Cacc[dt][et][r]);
            if (q == 0) *(LAS unsigned short*)(cp + 32 * PQ) = (unsigned short)f2bf(Cacc[2][et][0]); }
    }
}
}
__device__ __forceinline__ void mlstm_fast_unit(Frame& F, int b, int h, int db) {
    using namespace ml;
    LAS unsigned char* L = F.lds;
    int tid_ = threadIdx.x; asm volatile("" : "+v"(tid_));
    const int tid = tid_, l = tid & 63, w = __builtin_amdgcn_readfirstlane(tid >> 6);
    const int series = b * 4 + h;
    Src P; P.QCg = F.QC() + (size_t)b * SEQ * 512 + h * 128; P.KCg = F.KC() + (size_t)b * SEQ * 512 + h * 128;
    P.Vg = F.MIXB() + (size_t)4 * M * 512 + (size_t)b * SEQ * 512 + h * 128 + db * 32;
    P.MSg = F.MS() + (size_t)series * 4 * SEQ; P.CGg = F.DEC() + series * 128;
    float* HBg = F.HB() + (size_t)b * SEQ * 512 + h * 128 + db * 32;
    for (int i = tid; i < 2 * CBB / 4; i += 512) ((LAS unsigned*)(L + O_CB))[i] = 0u;
    for (int i = tid; i < 16 * PV / 4; i += 512) { ((LAS unsigned*)(L + O_VW + 32 * PV))[i] = 0u; ((LAS unsigned*)(L + BUF + O_VW + 32 * PV))[i] = 0u; }
    Stage S0, S1; float mst = 0.f;
    stage_load(S0, P, 0, tid); stage_load(S1, P, 1, tid);
    __syncthreads();
    stage_store(S0, L, tid, mst);
    f32x4 Cacc[3][2];
#pragma unroll
    for (int i = 0; i < 3; ++i)
#pragma unroll
        for (int k = 0; k < 2; ++k) Cacc[i][k] = (f32x4){0.f, 0.f, 0.f, 0.f};
    LAS float* dscr = (LAS float*)(L + O_DS + (w & 3) * 64);
    __syncthreads();
#pragma unroll 1
    for (int j = 0; j < SEQ / 64; j += 2) {
        if (j + 2 < SEQ / 64) stage_load(S0, P, j + 2, tid);
        chunk_step(L, L + O_CB, L + O_CB + CBB, dscr, HBg + (size_t)j * 64 * 512, Cacc, w, l);
        stage_store(S1, L + BUF, tid, mst);
        __syncthreads();
        if (j + 3 < SEQ / 64) stage_load(S1, P, j + 3, tid);
        chunk_step(L + BUF, L + O_CB + CBB, L + O_CB, dscr, HBg + (size_t)(j + 1) * 64 * 512, Cacc, w, l);
        if (j + 2 < SEQ / 64) stage_store(S0, L, tid, mst);
        __syncthreads();
    }
}

#ifndef NAIVE_ATTN
#define ATTN_UNIT attn_fast_unit
#else
#define ATTN_UNIT attn_naive_unit
#endif
#ifndef NAIVE_MLSTM
#define MLSTM_UNIT mlstm_fast_unit
#else
#define MLSTM_UNIT mlstm_naive_unit
#endif
#ifndef NPASS
#define NPASS 1
#endif
#ifndef P0SUB
#define P0SUB 0
#endif
#ifndef SKIP
#define SKIP 0
#endif
#define RUN(bit) ((PHM & (bit)) && (NPASS == 1 || pass_ == NPASS - 1 || !(SKIP & (bit))))
#ifndef PHM
#define PHM 0x3fff
#endif
#define GRID_BAR() do { xcd_barrier(bar); F.phase(); } while (0)
template <int pass_> __device__ __forceinline__ void forward_pass(Frame& F, const XcdBarrier& bar) {
    if (RUN(1)) { p0_prologue<(NPASS > 1 && pass_ == 0) ? P0SUB : 0>(F); }
    GRID_BAR();
    if (RUN(2)) { norm_mod_rows(F, F.x(), F.XN(), 0 * D, 1 * D); }
    GRID_BAR();
    if (RUN(4)) { pg8::Gemm g{F.XN(), F.W1I_t(), M, 2 * FF, D}; pg8::StaticOrder S; S.init(M, 2 * FF, F.G, (int)blockIdx.x);
      pg8::EpiSwiglu E{F.ACT(), FF};
      pg8::gemm_phase<pg8::EpiSwiglu, pg8::StaticOrder, true, true>(F.lds + RING_OFF, g, S, E); }
    GRID_BAR();
    if (RUN(8)) { pg8::Gemm g{F.ACT(), F.W1O_t(), M, D, FF}; pg8::StaticOrder S; S.init(M, D, F.G, (int)blockIdx.x);
      pg8::EpiResGate E{F.x(), F.out(), D, F.MOD() + 2 * D, NMOD, SEQ, 0.5f};
      pg8::gemm_phase<pg8::EpiResGate, pg8::StaticOrder, true, true>(F.lds + RING_OFF, g, S, E); }
    GRID_BAR();
    if (RUN(16)) norm_mod_rows(F, F.out(), F.XN(), 3 * D, 4 * D);
    GRID_BAR();
    if (RUN(32)) { pg8::Gemm g{F.XN(), F.WMI_t(), M, MIXNP, D}; pg8::StaticOrder S; S.init(M, MIXNP, F.G, (int)blockIdx.x);
      pg8::EpiMix E{F.Y(), F.MIXB(), (size_t)M * 512, F.GATES(), QSCALE};
      pg8::gemm_phase<pg8::EpiMix, pg8::StaticOrder, true, true>(F.lds + RING_OFF, g, S, E); }
    GRID_BAR();
    if (RUN(64)) { mixprep_phase(F); }
    GRID_BAR();
    if (RUN(8192)) for (;;) {
        if (F.tid == 0) F.MISC[16] = __hip_atomic_fetch_add(F.ctl() + CW_QUEUE + 64 * pass_, 1u, RLX_AGENT);
        __syncthreads();
        const int idx = (int)F.MISC[16];
        __syncthreads();
        if (idx >= 64 + 512) break;
#ifndef NO_MLSTM
        if (idx < 64) MLSTM_UNIT(F, idx >> 4, (idx >> 2) & 3, idx & 3);
#else
        if (idx < 64) {}
#endif
        else { const int a = idx - 64; ATTN_UNIT(F, (a & 31) >> 3, a & 7, 15 - (a >> 5)); }
    }
    GRID_BAR();
    if (RUN(128)) { mlstm_fixup_rows(F); }
    GRID_BAR();
    if (RUN(256)) { pg8::Gemm g{F.Y(), F.WMO_t(), M, D, D}; pg8::StaticOrder S; S.init(M, D, F.G, (int)blockIdx.x);
      pg8::EpiResGate E{F.out(), F.out(), D, F.MOD() + 5 * D, NMOD, SEQ, 1.0f};
      pg8::gemm_phase<pg8::EpiResGate, pg8::StaticOrder, true, true>(F.lds + RING_OFF, g, S, E); }
    GRID_BAR();
    if (RUN(512)) norm_mod_rows(F, F.out(), F.XN(), 6 * D, 7 * D);
    GRID_BAR();
    if (RUN(1024)) { pg8::Gemm g{F.XN(), F.W2I_t(), M, 2 * FF, D}; pg8::StaticOrder S; S.init(M, 2 * FF, F.G, (int)blockIdx.x);
      pg8::EpiSwiglu E{F.ACT(), FF};
      pg8::gemm_phase<pg8::EpiSwiglu, pg8::StaticOrder, true, true>(F.lds + RING_OFF, g, S, E); }
    GRID_BAR();
    if (RUN(2048)) { pg8::Gemm g{F.ACT(), F.W2O_t(), M, D, FF}; pg8::StaticOrder S; S.init(M, D, F.G, (int)blockIdx.x);
      pg8::EpiResGate E{F.out(), F.out(), D, F.MOD() + 8 * D, NMOD, SEQ, 0.5f};
      pg8::gemm_phase<pg8::EpiResGate, pg8::StaticOrder, true, true>(F.lds + RING_OFF, g, S, E); }
    GRID_BAR();
    if (RUN(4096)) final_norm_rows(F, F.out());
}

__global__ void __launch_bounds__(NWAVES * 64, 2) hymba_fwd(Args args) {
    extern __shared__ __attribute__((aligned(16))) unsigned char lds[];
    Frame F;
    F.lds = (LAS unsigned char*)lds;
    F.MISC = (volatile LAS unsigned*)(F.lds + MISC_OFF);
    F.tid = threadIdx.x; F.lane = F.tid & 63; F.wave = __builtin_amdgcn_readfirstlane(F.tid >> 6);
    F.G = gridDim.x; { const int bx = blockIdx.x; F.vcu = (F.G % 8 == 0) ? (bx % 8) * (F.G / 8) + bx / 8 : bx; }
    F.phase();
    for (int u = F.tid; u < (LDS_BYTES - LDSCTL_OFF) / 4; u += NWAVES * 64) ((LAS unsigned*)(F.lds + LDSCTL_OFF))[u] = 0u;
    __syncthreads();
    XcdBarrier bar = xcd_barrier_post((unsigned*)(F.ctl() + CW_BAR), F.MISC + 8);

    forward_pass<0>(F, bar);
#if NPASS > 1
    GRID_BAR(); forward_pass<1>(F, bar);
#endif
}

extern "C" void kernel_launch(void* const* d_in, const int* in_sizes, int n_in, void* d_out, int out_size, void* d_ws, size_t ws_size, hipStream_t stream) {
    static int grid = 0;
    if (grid == 0) {
        if (n_in != 17 || in_sizes[0] != M * D || out_size != M * D || ws_size < WS_END) { fprintf(stderr, "kernel_launch: unexpected shapes (n_in %d, in0 %d, out %d, ws %zu); nothing launched\n", n_in, n_in > 0 ? in_sizes[0] : -1, out_size, ws_size); grid = -1; return; }
        int dev = 0, cus = 0, per_cu = 0;
        if (hipGetDevice(&dev) != hipSuccess || hipDeviceGetAttribute(&cus, hipDeviceAttributeMultiprocessorCount, dev) != hipSuccess) { fprintf(stderr, "kernel_launch: device query failed\n"); grid = -1; return; }
        if (hipFuncSetAttribute((const void*)hymba_fwd, hipFuncAttributeMaxDynamicSharedMemorySize, LDS_BYTES) != hipSuccess) { fprintf(stderr, "kernel_launch: hipFuncSetAttribute failed\n"); grid = -1; return; }
        if (hipOccupancyMaxActiveBlocksPerMultiprocessor(&per_cu, (const void*)hymba_fwd, NWAVES * 64, LDS_BYTES) != hipSuccess || per_cu < 1) { fprintf(stderr, "kernel_launch: occupancy query reports %d workgroups per CU; nothing launched\n", per_cu); (void)hipGetLastError(); grid = -1; return; }
        grid = cus;
    }
    if (grid < 0) return;
    if (hipMemsetAsync((char*)d_ws + WS_CTL, 0, CTL_ZERO_BYTES, stream) != hipSuccess) { fprintf(stderr, "kernel_launch: hipMemsetAsync failed\n"); return; }
    Args a{};
    for (int i = 0; i < 17; ++i) a.in[i] = (const float*)d_in[i];
    a.out = (float*)d_out; a.ws = (unsigned char*)d_ws;
    hipLaunchKernelGGL(hymba_fwd, dim3(grid), dim3(NWAVES * 64), LDS_BYTES, stream, a);
    const hipError_t le = hipPeekAtLastError();
    if (le != hipSuccess) fprintf(stderr, "kernel_launch: launch failed: %s\n", hipGetErrorName(le));
}
```
